# Optimizing an MI355X kernel written in HIP

```python
import math
import jax, jax.numpy as jnp
from jax import lax
import numpy as np

D_MODEL = 1024
BATCH = 8
SEQ = 2048
DEPTH = 4

GRID_W = 64
CTX_LEN = 256
N_MOD = 9
D_FF = int(math.ceil(8 * D_MODEL / 3 / 128)) * 128
FFN_RES = 0.5
ROPE_BASE = 10000.0
EPS = 1e-6
NEG_INF = -1e30

A_WIDTH = D_MODEL // 4
A_HEADS = 4
A_HEAD_DIM = A_WIDTH // A_HEADS
CHUNK = 128
B_WIDTH = D_MODEL // 2
B_HEADS = 4
B_V_DIM = B_WIDTH // B_HEADS
B_QK_DIM = B_V_DIM // 2
C_WIDTH = D_MODEL // 4
C_HEAD_DIM = 64
C_HEADS = C_WIDTH // C_HEAD_DIM
C_KV_HEADS = 2
C_GROUP = C_HEADS // C_KV_HEADS
WINDOW = 128
BLK = 128
D_MIX = A_WIDTH + B_WIDTH + C_WIDTH

W_UV_A = 2 * A_WIDTH
W_Q_B = B_HEADS * 2 * B_QK_DIM
W_Q_C = C_HEADS * C_HEAD_DIM
W_K_B = B_HEADS * 2 * B_QK_DIM
W_V_B = B_HEADS * B_V_DIM
W_K_C = C_KV_HEADS * C_HEAD_DIM
W_V_C = C_KV_HEADS * C_HEAD_DIM
IN_COLS = W_UV_A + W_Q_B + W_Q_C + W_K_B + W_V_B + W_K_C + W_V_C
KV_START = W_UV_A + W_Q_B + W_Q_C
SPLITS = (W_UV_A, W_UV_A + W_Q_B, KV_START, KV_START + W_K_B, KV_START + W_K_B + W_V_B,
          KV_START + W_K_B + W_V_B + W_K_C)
KV_SPLITS = (W_K_B, W_K_B + W_V_B, W_K_B + W_V_B + W_K_C)

kernel_name = 'hybrid_diffusion_trunk'


def rmsnorm(x, g):
    xf = x.astype(jnp.float32)
    y = xf * lax.rsqrt(jnp.mean(xf * xf, axis=-1, keepdims=True) + EPS)
    return (y * g.astype(jnp.float32)).astype(x.dtype)


def axial_rope_tables(rows, dim):
    row = jnp.repeat(jnp.arange(rows, dtype=jnp.float32), GRID_W)
    col = jnp.tile(jnp.arange(GRID_W, dtype=jnp.float32), rows)
    quarter = dim // 4
    inv = ROPE_BASE ** (-jnp.arange(quarter, dtype=jnp.float32) / quarter)
    ar = row[:, None] * inv[None, :]
    ac = col[:, None] * inv[None, :]
    ang = jnp.concatenate([ar, ar, ac, ac], axis=-1)
    return jnp.cos(ang), jnp.sin(ang)


def apply_rope(x, cos, sin):
    shape = (x.shape[1],) + (1,) * (x.ndim - 3) + (x.shape[-1],)
    cos = cos.reshape(shape).astype(x.dtype)
    sin = sin.reshape(shape).astype(x.dtype)
    x1, x2, x3, x4 = jnp.split(x, 4, axis=-1)
    rot = jnp.concatenate([-x2, x1, -x4, x3], axis=-1)
    return x * cos + rot * sin


def adaln_in(s, g_pre, shift, scale):
    return rmsnorm(s, g_pre) * (1 + scale) + shift


def adaln_out(s, y, g_post, gate, weight):
    return s + weight * gate * rmsnorm(y, g_post)


def swiglu(y, wg, wu, wd):
    return (jax.nn.silu(y @ wg) * (y @ wu)) @ wd


def ffn_sublayer(s, mod, j, g_pre, g_post, wg, wu, wd):
    y = adaln_in(s, g_pre, mod[..., 3 * j, :, :], mod[..., 3 * j + 1, :, :])
    return adaln_out(s, swiglu(y, wg, wu, wd), g_post, mod[..., 3 * j + 2, :, :], FFN_RES)


def chunk_gmlp(uv, v_gain, w_s, b_s):
    b_, l_, _ = uv.shape
    u, v = jnp.split(jax.nn.gelu(uv), 2, axis=-1)
    v = rmsnorm(v.reshape(b_, l_, A_HEADS, A_HEAD_DIM), v_gain)
    v = v.reshape(b_, l_ // CHUNK, CHUNK, A_HEADS, A_HEAD_DIM)
    mixed = jnp.einsum('hpq,bnqhc->bnphc', w_s, v) + b_s.T[:, :, None]
    return u * mixed.reshape(b_, l_, A_WIDTH)


def diff_softmax(q, k, v, lam):
    s = jnp.einsum('bqhmd,bkhmd->bhmqk', q, k).astype(jnp.float32) * (B_QK_DIM ** -0.5)
    p = jax.nn.softmax(s, axis=-1)
    w = p[:, :, 0] - lam * p[:, :, 1]
    return jnp.einsum('bhqk,bkhe->bqhe', w.astype(v.dtype), v)


def diff_attention_latent(q, k_all, v_all, lam):
    b_, l_ = q.shape[:2]
    nb = l_ // BLK
    qb = jnp.moveaxis(q.reshape((b_, nb, BLK) + q.shape[2:]), 1, 0)
    ob = lax.map(lambda qi: diff_softmax(qi, k_all, v_all, lam), qb)
    return jnp.moveaxis(ob, 0, 1).reshape((b_, l_) + ob.shape[3:])


def diff_post(o, g_sub, lam_init):
    return (rmsnorm(o, g_sub) * (1 - lam_init)).reshape(o.shape[0], o.shape[1], -1)


def swa_latent(q, k, v, kc, vc, sink):
    b_, l_ = q.shape[:2]
    nb = l_ // BLK
    qb = q.reshape(b_, nb, BLK, C_KV_HEADS, C_GROUP, C_HEAD_DIM)
    pad = ((0, 0), (1, 1), (0, 0), (0, 0), (0, 0))
    kp = jnp.pad(k.reshape(b_, nb, BLK, C_KV_HEADS, C_HEAD_DIM), pad)
    vp = jnp.pad(v.reshape(b_, nb, BLK, C_KV_HEADS, C_HEAD_DIM), pad)
    kband = jnp.concatenate([kp[:, :-2], kp[:, 1:-1], kp[:, 2:]], axis=2)
    vband = jnp.concatenate([vp[:, :-2], vp[:, 1:-1], vp[:, 2:]], axis=2)
    scale = C_HEAD_DIM ** -0.5
    s_band = jnp.einsum('bnqkgd,bnjkd->bnkgqj', qb, kband).astype(jnp.float32) * scale
    blk = jnp.arange(nb)
    qpos = blk[:, None] * BLK + jnp.arange(BLK)[None, :]
    kpos = (blk[:, None] - 1) * BLK + jnp.arange(3 * BLK)[None, :]
    valid = ((jnp.abs(qpos[:, :, None] - kpos[:, None, :]) <= WINDOW)
             & (kpos[:, None, :] >= 0) & (kpos[:, None, :] < l_))
    s_band = jnp.where(valid[None, :, None, None], s_band, NEG_INF)
    s_ctx = jnp.einsum('bnqkgd,bckd->bnkgqc', qb, kc).astype(jnp.float32) * scale
    s_sink = jnp.broadcast_to(sink.astype(jnp.float32)[None, None, :, :, None, None],
                              s_band.shape[:-1] + (1,))
    p = jax.nn.softmax(jnp.concatenate([s_band, s_ctx, s_sink], axis=-1), axis=-1)
    p_band = p[..., :3 * BLK].astype(v.dtype)
    p_ctx = p[..., 3 * BLK:-1].astype(v.dtype)
    out = (jnp.einsum('bnkgqj,bnjkd->bnqkgd', p_band, vband)
           + jnp.einsum('bnkgqc,bckd->bnqkgd', p_ctx, vc))
    return out.reshape(b_, l_, C_WIDTH)


def swa_context(q, kc, vc, sink):
    b_, l_ = q.shape[:2]
    s = jnp.einsum('bqkgd,bckd->bkgqc', q, kc).astype(jnp.float32) * (C_HEAD_DIM ** -0.5)
    s_sink = jnp.broadcast_to(sink.astype(jnp.float32)[None, :, :, None, None], s.shape[:-1] + (1,))
    p = jax.nn.softmax(jnp.concatenate([s, s_sink], axis=-1), axis=-1)[..., :-1]
    out = jnp.einsum('bkgqc,bckd->bqkgd', p.astype(vc.dtype), vc)
    return out.reshape(b_, l_, C_WIDTH)


def setup_inputs(seed: int = 0) -> dict:
    key = jax.random.key(seed)
    ks = jax.random.split(key, 19)
    f32 = jnp.float32
    nrm = lambda k, shape, s: jax.random.normal(k, shape, f32) * s
    return {
        'x': nrm(ks[0], (BATCH, SEQ, D_MODEL), 1.0),
        'c': nrm(ks[1], (BATCH, D_MODEL), 1.0),
        'ctx': nrm(ks[2], (BATCH, CTX_LEN, D_MODEL), 1.0),
        'c_ctx': nrm(ks[3], (D_MODEL,), 1.0),
        'w_mod': nrm(ks[4], (DEPTH, D_MODEL, N_MOD * D_MODEL), 0.5 * D_MODEL ** -0.5),
        'b_mod': nrm(ks[5], (DEPTH, N_MOD * D_MODEL), 0.01),
        'norm_pre': 1.0 + nrm(ks[6], (DEPTH, 3, D_MODEL), 0.02),
        'norm_post': 1.0 + nrm(ks[7], (DEPTH, 3, D_MODEL), 0.02),
        'ffn_w_gate': nrm(ks[8], (DEPTH, 2, D_MODEL, D_FF), D_MODEL ** -0.5),
        'ffn_w_up': nrm(ks[9], (DEPTH, 2, D_MODEL, D_FF), D_MODEL ** -0.5),
        'ffn_w_down': nrm(ks[10], (DEPTH, 2, D_FF, D_MODEL), D_FF ** -0.5),
        'w_in': nrm(ks[11], (DEPTH, D_MODEL, IN_COLS), D_MODEL ** -0.5),
        'w_out': nrm(ks[12], (DEPTH, D_MIX, D_MODEL), D_MIX ** -0.5),
        'gmlp_v_gain': 1.0 + nrm(ks[13], (DEPTH, A_HEADS, A_HEAD_DIM), 0.02),
        'gmlp_w_s': nrm(ks[14], (DEPTH, A_HEADS, CHUNK, CHUNK), CHUNK ** -0.5),
        'gmlp_b_s': nrm(ks[15], (DEPTH, A_HEADS, CHUNK), 0.02),
        'diff_lambda': nrm(ks[16], (DEPTH, 4, B_QK_DIM), 0.1),
        'diff_subln': 1.0 + nrm(ks[17], (DEPTH, B_V_DIM), 0.02),
        'swa_sink': nrm(ks[18], (DEPTH, C_HEADS), 0.5),
    }


def reference(x, c, ctx, c_ctx, w_mod, b_mod, norm_pre, norm_post, ffn_w_gate, ffn_w_up, ffn_w_down,
              w_in, w_out, gmlp_v_gain, gmlp_w_s, gmlp_b_s, diff_lambda, diff_subln, swa_sink):
    b_, l_, _ = x.shape
    c_len = ctx.shape[1]
    ROWS = l_ // GRID_W
    cos_b, sin_b = axial_rope_tables(ROWS, B_QK_DIM)
    cos_c, sin_c = axial_rope_tables(ROWS, C_HEAD_DIM)
    sc = jax.nn.silu(c)
    scc = jax.nn.silu(c_ctx)
    h = ctx
    for l in range(DEPTH):
        last = l == DEPTH - 1
        mod_x = (sc @ w_mod[l] + b_mod[l]).reshape(b_, N_MOD, 1, D_MODEL)
        mod_h = (scc @ w_mod[l] + b_mod[l]).reshape(N_MOD, 1, D_MODEL)
        lam_init = 0.8 - 0.6 * math.exp(-0.3 * l)
        lam_p = diff_lambda[l].astype(jnp.float32)
        lam = (jnp.exp(jnp.sum(lam_p[0] * lam_p[1])) - jnp.exp(jnp.sum(lam_p[2] * lam_p[3])) + lam_init)
        sink = swa_sink[l].reshape(C_KV_HEADS, C_GROUP)

        f0 = (norm_pre[l, 0], norm_post[l, 0], ffn_w_gate[l, 0], ffn_w_up[l, 0], ffn_w_down[l, 0])
        x = ffn_sublayer(x, mod_x, 0, *f0)
        h = ffn_sublayer(h, mod_h, 0, *f0)

        ax = adaln_in(x, norm_pre[l, 1], mod_x[:, 3], mod_x[:, 4])
        ah = adaln_in(h, norm_pre[l, 1], mod_h[3], mod_h[4])
        uv_x, qb_x, qc_x, kb_x, vb_x, kc_x, vc_x = jnp.split(ax @ w_in[l], SPLITS, axis=-1)
        if last:
            kb_h, vb_h, kc_h, vc_h = jnp.split(ah @ w_in[l][:, KV_START:], KV_SPLITS, axis=-1)
        else:
            uv_h, qb_h, qc_h, kb_h, vb_h, kc_h, vc_h = jnp.split(ah @ w_in[l], SPLITS, axis=-1)
        kb_h = kb_h.reshape(b_, c_len, B_HEADS, 2, B_QK_DIM)
        vb_h = vb_h.reshape(b_, c_len, B_HEADS, B_V_DIM)
        kc_h = kc_h.reshape(b_, c_len, C_KV_HEADS, C_HEAD_DIM)
        vc_h = vc_h.reshape(b_, c_len, C_KV_HEADS, C_HEAD_DIM)
        qb_x = apply_rope(qb_x.reshape(b_, l_, B_HEADS, 2, B_QK_DIM), cos_b, sin_b)
        kb_x = apply_rope(kb_x.reshape(b_, l_, B_HEADS, 2, B_QK_DIM), cos_b, sin_b)
        vb_x = vb_x.reshape(b_, l_, B_HEADS, B_V_DIM)
        qc_x = apply_rope(qc_x.reshape(b_, l_, C_KV_HEADS, C_GROUP, C_HEAD_DIM), cos_c, sin_c)
        kc_x = apply_rope(kc_x.reshape(b_, l_, C_KV_HEADS, C_HEAD_DIM), cos_c, sin_c)
        vc_x = vc_x.reshape(b_, l_, C_KV_HEADS, C_HEAD_DIM)

        o_a = chunk_gmlp(uv_x, gmlp_v_gain[l], gmlp_w_s[l], gmlp_b_s[l])
        k_all = jnp.concatenate([kb_h, kb_x], axis=1)
        v_all = jnp.concatenate([vb_h, vb_x], axis=1)
        o_b = diff_post(diff_attention_latent(qb_x, k_all, v_all, lam), diff_subln[l], lam_init)
        o_c = swa_latent(qc_x, kc_x, vc_x, kc_h, vc_h, sink)
        mix_x = jnp.concatenate([o_a, o_b, o_c], axis=-1) @ w_out[l]
        x = adaln_out(x, mix_x, norm_post[l, 1], mod_x[:, 5], 1.0)
        if not last:
            qb_h = qb_h.reshape(b_, c_len, B_HEADS, 2, B_QK_DIM)
            qc_h = qc_h.reshape(b_, c_len, C_KV_HEADS, C_GROUP, C_HEAD_DIM)
            oh_a = chunk_gmlp(uv_h, gmlp_v_gain[l], gmlp_w_s[l], gmlp_b_s[l])
            oh_b = diff_post(diff_softmax(qb_h, kb_h, vb_h, lam), diff_subln[l], lam_init)
            oh_c = swa_context(qc_h, kc_h, vc_h, sink)
            mix_h = jnp.concatenate([oh_a, oh_b, oh_c], axis=-1) @ w_out[l]
            h = adaln_out(h, mix_h, norm_post[l, 1], mod_h[5], 1.0)

        f1 = (norm_pre[l, 2], norm_post[l, 2], ffn_w_gate[l, 1], ffn_w_up[l, 1], ffn_w_down[l, 1])
        x = ffn_sublayer(x, mod_x, 2, *f1)
        if not last:
            h = ffn_sublayer(h, mod_h, 2, *f1)
    return x
```

```cpp
#include <hip/hip_runtime.h>
#include <hip/hip_cooperative_groups.h>
#include <cstdio>
#include <cstdint>
namespace cg = cooperative_groups;

#define LAS __attribute__((address_space(3)))
typedef unsigned short bf16_t;
typedef short bf16x8 __attribute__((ext_vector_type(8)));
typedef short s16x4 __attribute__((ext_vector_type(4)));
typedef float f32x4 __attribute__((ext_vector_type(4)));
typedef float f32x2 __attribute__((ext_vector_type(2)));
typedef unsigned u32x4 __attribute__((ext_vector_type(4)));
typedef unsigned u32x2 __attribute__((ext_vector_type(2)));

constexpr int DM = 1024, NB = 8, SEQ = 2048, CTXL = 256, DEPTH = 4, DFF = 2816, NGU = 2 * DFF, INC = 2560, NKEY = SEQ + CTXL;
constexpr int T_LAT = NB * SEQ, T_CTX = NB * CTXL, TT = T_LAT + T_CTX;
constexpr float EPSV = 1e-6f;
constexpr float QSCALE = 0.125f * 1.4426950408889634f;
constexpr float LOG2E = 1.4426950408889634f;

constexpr size_t MiB = 1u << 20;
constexpr size_t WS_MOD = 1 * MiB;
constexpr size_t WS_ROPE = 3 * MiB;
constexpr size_t WS_LAM = 3 * MiB + 65536;
constexpr size_t WS_WS = 4 * MiB;
constexpr size_t WS_WGU = 8 * MiB;
constexpr size_t WS_WD = 96 * MiB;
constexpr size_t WS_WIN = 140 * MiB;
constexpr size_t WS_WOUT = 160 * MiB;
constexpr size_t WS_H = 168 * MiB;
constexpr size_t WS_S16 = 276 * MiB;
constexpr size_t WS_Y = 176 * MiB;
constexpr size_t WS_Z = 212 * MiB;
constexpr size_t WS_R1 = 340 * MiB;
constexpr size_t R1_UV = WS_R1;
constexpr size_t R1_QB = R1_UV + (size_t)TT * 512 * 2;
constexpr size_t R1_QC = R1_QB + (size_t)TT * 512 * 2;
constexpr size_t R1_KB = R1_QC + (size_t)TT * 256 * 2;
constexpr size_t R1_VB = R1_KB + (size_t)NB * 4 * NKEY * 128 * 2;
constexpr size_t R1_KC = R1_VB + (size_t)NB * 4 * NKEY * 128 * 2;
constexpr size_t R1_VC = R1_KC + (size_t)NB * 2 * NKEY * 64 * 2;
constexpr size_t R1_O = R1_VC + (size_t)NB * 2 * NKEY * 64 * 2;
constexpr size_t WS_END = R1_O + (size_t)TT * 1024 * 2;
static_assert(WS_Z + (size_t)(T_LAT + 8 * T_CTX) * DM * 4 <= WS_R1 && WS_R1 + (size_t)TT * DFF * 2 <= 476 * MiB && WS_END <= 476 * MiB, "ws map");
constexpr size_t WS_NEED = 476 * MiB;

constexpr int LDS_BYTES = 131072 + 2048;
constexpr int NPHASE = 2 + 10 * DEPTH;

__device__ __forceinline__ unsigned cvt_pk_bf16(float lo, float hi) { unsigned r; asm volatile("v_cvt_pk_bf16_f32 %0, %1, %2" : "=v"(r) : "v"(lo), "v"(hi)); return r; }
__device__ __forceinline__ float wave_sum(float v) {
#pragma unroll
    for (int o = 1; o < 64; o <<= 1) v += __shfl_xor(v, o);
    return v;
}
__device__ __forceinline__ float fmax2(float a, float b) { return __builtin_amdgcn_fmed3f(a, b, 3.0e38f); }
__device__ __forceinline__ float silu_f(float g) { return g * __builtin_amdgcn_rcpf(1.f + __expf(-g)); }
__device__ __forceinline__ float gelu_tanh_f(float x) { const float y = 1.5957691216057308f * (x + 0.044715f * x * x * x); return x * __builtin_amdgcn_rcpf(1.f + __expf(-y)); }

namespace pg8 {
constexpr int BM = 256, BK = 64, HALF = 128, HTB = HALF * BK * 2, STAGE_BYTES = 8 * HTB, NXCD = 8, WGM = 8;
__host__ __device__ __forceinline__ int lds_byte(int r, int c) { const int st = (r >> 4) * 2 + (c >> 5), rr = r & 15, cc = c & 31, ob = rr * 64 + cc * 2; return st * 1024 + (ob ^ (((ob >> 9) & 1) << 5)); }
__host__ __device__ __forceinline__ void stage_rc(int b, int& R, int& C) { const int st = b / 1024, sb = b % 1024, swz = sb ^ (((sb >> 9) & 1) << 5); R = (st >> 1) * 16 + swz / 64; C = (st & 1) * 32 + (swz % 64) / 2; }
__host__ __device__ __forceinline__ int perm32(int rho) { const int n = rho >> 4, i = rho & 15; return 8 * (i >> 2) + 4 * n + (i & 3); }

struct Unit { int pm, pn, k0, nk, part; };
struct Gemm { const bf16_t* A; const bf16_t* Bt; int M, N, K; };

struct StaticOrder {
    int nM, nN, nwg, G, c, nkt;
    __host__ __device__ void init(int M, int N, int G_, int c_) { nM = M / BM; nN = N / BM; nwg = nM * nN; G = G_; c = c_; nkt = 0; }
    __host__ __device__ bool next(int i, Unit& u) const {
        const long L = (long)i * G + c; if (L >= nwg) return false;
        int wgid = (int)L; { const int q = nwg / NXCD, r = nwg % NXCD, xcd = wgid % NXCD, off = wgid / NXCD; wgid = (xcd < r ? xcd * (q + 1) : r * (q + 1) + (xcd - r) * q) + off; }
        const int nig = WGM * nN, gid = wgid / nig, fm = gid * WGM, gsz = (nM - fm) < WGM ? (nM - fm) : WGM;
        u.pm = fm + ((wgid % nig) % gsz); u.pn = (wgid % nig) / gsz; u.k0 = 0; u.nk = nkt; u.part = -1; return true;
    }
    __device__ __forceinline__ void a_ready(const Unit&) const {}
    __device__ __forceinline__ void done(const Unit&) const {}
};
struct SplitOrder {
    int G, c, nitems, nkt;
    __host__ __device__ void init(int M, int K, int G_, int c_) { G = G_; c = c_; nkt = K / BK; nitems = 256 + (M > T_LAT ? 256 : 0); }
    __host__ __device__ bool next(int i, Unit& u) const {
        const int L = i * G + c; if (L >= nitems) return false;
        const int w = (L & 7) * 32 + ((L >> 3) & 31), lpm = (w >> 5) * 8 + (w & 7), lpn = (w & 31) >> 3;
        const int v = L - 256, cu = v >> 3, part = v & 7;
        const bool ctx = L >= 256;
        const int ck0 = (nkt == 44) ? (part < 6 ? 6 * part : 36 + 4 * (part - 6)) : part * (nkt >> 3);
        const int cnk = (nkt == 44) ? (part < 6 ? 6 : 4) : (nkt >> 3);
        u.pm = ctx ? 64 + (cu >> 2) : lpm; u.pn = ctx ? (cu & 3) : lpn; u.part = ctx ? part : -1; u.k0 = ctx ? ck0 : 0; u.nk = ctx ? cnk : nkt;
        return true;
    }
    __device__ __forceinline__ void a_ready(const Unit&) const {}
    __device__ __forceinline__ void done(const Unit&) const {}
};


struct EpiSwiGLU {
    static constexpr bool PERM = true, AFTER_DRAIN = false;
    bf16_t* O;
    __device__ __forceinline__ void operator()(const f32x4 (&acc)[2][2][4][2], const Unit& u, int wr, int wc, int fr, int fq) const {
        const int row0 = u.pm * BM + wr * 64 + fr, col0 = u.pn * 128 + wc * 32 + 8 * fq;
#pragma unroll
        for (int ai = 0; ai < 2; ++ai)
#pragma unroll
            for (int m = 0; m < 4; ++m) {
                bf16_t* p = O + (size_t)(row0 + ai * HALF + m * 16) * DFF + col0;
                const f32x4 g0 = acc[ai][0][m][0], g1 = acc[ai][0][m][1], u0 = acc[ai][1][m][0], u1 = acc[ai][1][m][1];
                u32x4 w;
#define SGLU(g_, u_) ((g_) * (u_) * __builtin_amdgcn_rcpf(1.f + __builtin_amdgcn_exp2f(-(g_))))
                w.x = cvt_pk_bf16(SGLU(g0[0], u0[0]), SGLU(g0[1], u0[1])); w.y = cvt_pk_bf16(SGLU(g0[2], u0[2]), SGLU(g0[3], u0[3]));
                w.z = cvt_pk_bf16(SGLU(g1[0], u1[0]), SGLU(g1[1], u1[1])); w.w = cvt_pk_bf16(SGLU(g1[2], u1[2]), SGLU(g1[3], u1[3]));
#undef SGLU
                *(u32x4*)p = w;
            }
    }
};
struct EpiZ16 {
    static constexpr bool PERM = true, AFTER_DRAIN = false;
    bf16_t* Z;
    __device__ __forceinline__ void operator()(const f32x4 (&acc)[2][2][4][2], const Unit& u, int wr, int wc, int fr, int fq) const {
        const int row0 = u.pm * BM + wr * 64 + fr + (u.part > 0 ? u.part * T_CTX : 0), col0 = u.pn * BM + wc * 32 + 8 * fq;
#pragma unroll
        for (int ai = 0; ai < 2; ++ai)
#pragma unroll
            for (int m = 0; m < 4; ++m) {
                bf16_t* p = Z + (size_t)(row0 + ai * HALF + m * 16) * DM + col0;
#pragma unroll
                for (int bj = 0; bj < 2; ++bj) { const f32x4 v0 = acc[ai][bj][m][0], v1 = acc[ai][bj][m][1];
                    *(u32x4*)(p + bj * HALF) = (u32x4){cvt_pk_bf16(v0[0], v0[1]), cvt_pk_bf16(v0[2], v0[3]), cvt_pk_bf16(v1[0], v1[1]), cvt_pk_bf16(v1[2], v1[3])}; }
            }
    }
};
struct EpiInProj {
    static constexpr bool PERM = false, AFTER_DRAIN = false;
    bf16_t *UV, *QB, *QC, *KB, *VBt, *KC, *VCt; const f32x2* rope;
    __device__ __forceinline__ void operator()(const f32x4 (&acc)[2][2][4][2], const Unit& u, int wr, int wc, int fr, int fq) const {
        const int pn = u.pn; const bool lat = u.pm < (T_LAT / BM);
#pragma unroll
        for (int ai = 0; ai < 2; ++ai)
#pragma unroll
            for (int m = 0; m < 4; ++m) {
                const int r = u.pm * BM + ai * HALF + wr * 64 + m * 16 + fr;
                int b, s, keyidx;
                if (lat) { b = r >> 11; s = r & 2047; keyidx = CTXL + s; } else { const int rc = r - T_LAT; b = rc >> 8; s = 0; keyidx = rc & 255; }
#pragma unroll
                for (int bj = 0; bj < 2; ++bj) {
                    f32x4 v0 = acc[ai][bj][m][0], v1 = acc[ai][bj][m][1];
                    const bool is_rope = (pn >= 2 && pn <= 6) || (pn == 9 && bj == 0);
                    if (is_rope && lat) {
                        const int pos = (wc & 1) ? (s & 63) : (s >> 6);
                        const f32x4 c01 = *(const f32x4*)(rope + pos * 16 + 4 * fq), c23 = *(const f32x4*)(rope + pos * 16 + 4 * fq + 2);
                        const float cs[4] = {c01[0], c01[2], c23[0], c23[2]}, sn[4] = {c01[1], c01[3], c23[1], c23[3]};
#pragma unroll
                        for (int i = 0; i < 4; ++i) { const float x0 = v0[i], x1 = v1[i]; v0[i] = x0 * cs[i] - x1 * sn[i]; v1[i] = x1 * cs[i] + x0 * sn[i]; }
                    }
                    const int ctb = bj * HALF + wc * 32 + 4 * fq;
                    if (pn <= 1) {
#pragma unroll
                        for (int i = 0; i < 4; ++i) { v0[i] = gelu_tanh_f(v0[i]); v1[i] = gelu_tanh_f(v1[i]); }
                        bf16_t* p = UV + (size_t)r * 512 + pn * 256 + ctb;
                        *(u32x2*)p = (u32x2){cvt_pk_bf16(v0[0], v0[1]), cvt_pk_bf16(v0[2], v0[3])}; *(u32x2*)(p + 16) = (u32x2){cvt_pk_bf16(v1[0], v1[1]), cvt_pk_bf16(v1[2], v1[3])};
                    } else if (pn <= 4) {
                        v0 = v0 * QSCALE; v1 = v1 * QSCALE;
                        bf16_t* p = (pn <= 3) ? QB + (size_t)r * 512 + (pn - 2) * 256 + ctb : QC + (size_t)r * 256 + ctb;
                        *(u32x2*)p = (u32x2){cvt_pk_bf16(v0[0], v0[1]), cvt_pk_bf16(v0[2], v0[3])}; *(u32x2*)(p + 16) = (u32x2){cvt_pk_bf16(v1[0], v1[1]), cvt_pk_bf16(v1[2], v1[3])};
                    } else if (pn <= 6) {
                        const int ck = (pn - 5) * 256 + ctb, head = ck >> 7, cw = ck & 127;
                        bf16_t* p = KB + ((size_t)(b * 4 + head) * NKEY + keyidx) * 128 + cw;
                        *(u32x2*)p = (u32x2){cvt_pk_bf16(v0[0], v0[1]), cvt_pk_bf16(v0[2], v0[3])}; *(u32x2*)(p + 16) = (u32x2){cvt_pk_bf16(v1[0], v1[1]), cvt_pk_bf16(v1[2], v1[3])};
                    } else if (pn <= 8) {
                        const int cv = (pn - 7) * 256 + ctb, head = cv >> 7, e = cv & 127;
                        bf16_t* p = VBt + ((size_t)(b * 4 + head) * NKEY + keyidx) * 128 + e;
                        *(u32x2*)p = (u32x2){cvt_pk_bf16(v0[0], v0[1]), cvt_pk_bf16(v0[2], v0[3])}; *(u32x2*)(p + 16) = (u32x2){cvt_pk_bf16(v1[0], v1[1]), cvt_pk_bf16(v1[2], v1[3])};
                    } else {
                        const int kv = wc >> 1, d = (wc & 1) * 32 + 4 * fq;
                        if (bj == 0) {
                            bf16_t* p = KC + ((size_t)(b * 2 + kv) * NKEY + keyidx) * 64 + d;
                            *(u32x2*)p = (u32x2){cvt_pk_bf16(v0[0], v0[1]), cvt_pk_bf16(v0[2], v0[3])}; *(u32x2*)(p + 16) = (u32x2){cvt_pk_bf16(v1[0], v1[1]), cvt_pk_bf16(v1[2], v1[3])};
                        } else {
                            bf16_t* p = VCt + ((size_t)(b * 2 + kv) * NKEY + keyidx) * 64 + d;
                            *(u32x2*)p = (u32x2){cvt_pk_bf16(v0[0], v0[1]), cvt_pk_bf16(v0[2], v0[3])}; *(u32x2*)(p + 16) = (u32x2){cvt_pk_bf16(v1[0], v1[1]), cvt_pk_bf16(v1[2], v1[3])};
                        }
                    }
                }
                asm volatile("" ::: "memory");
            }
    }
};

template <class Epi, class Sched, bool ALIGN_EPI = false, bool SP2 = false>
__device__ __forceinline__ void gemm_phase(LAS unsigned char* lds, const Gemm g, const Sched& S, const Epi& E, const int tid) {
    const int wid = __builtin_amdgcn_readfirstlane(tid >> 6), lane = tid & 63, wr = wid >> 2, wc = wid & 3, fr = lane & 15, fq = lane >> 4;
    const int K = g.K;
    unsigned voffA[2], voffB[2];
#pragma unroll
    for (int i = 0; i < 2; ++i) { int R, C; stage_rc(tid * 16 + i * 8192, R, C); const int Rb = Epi::PERM ? ((R & ~31) + perm32(R & 31)) : R;
        voffA[i] = (unsigned)(R * K + C) * 2u; voffB[i] = (unsigned)(Rb * K + C) * 2u; }
    const size_t kstep = (size_t)(BK * 2);
    const size_t hstep = (size_t)HALF * K * 2;
    const size_t tstep = 2 * hstep;
    const unsigned ldsw = (unsigned)wid * 1024u;
    const int aoff = lds_byte(wr * 64 + fr, fq * 8), boff = lds_byte(wc * 32 + fr, fq * 8);
#define PG8_SA(b, h) (((b) * 2 + (h)) * HTB)
#define PG8_SB(b, h) ((4 + (b) * 2 + (h)) * HTB)
#define PG8_STAGE(bufoff, gbase, voff) do { _Pragma("unroll") for (int _i = 0; _i < 2; ++_i) \
        __builtin_amdgcn_global_load_lds((const unsigned*)((const char*)(gbase) + (voff)[_i]), (LAS unsigned*)(lds + (bufoff) + ldsw + _i * 8192), 16, 0, 0); } while (0)
#define PG8_LDA(dst, b, h) do { _Pragma("unroll") for (int m = 0; m < 4; ++m) _Pragma("unroll") for (int k = 0; k < 2; ++k) dst[m][k] = *(const LAS bf16x8*)(lds + PG8_SA(b, h) + aoff + m * 2048 + k * 1024); } while (0)
#define PG8_LDB(dst, b, h) do { _Pragma("unroll") for (int n = 0; n < 2; ++n) _Pragma("unroll") for (int k = 0; k < 2; ++k) dst[n][k] = *(const LAS bf16x8*)(lds + PG8_SB(b, h) + boff + n * 2048 + k * 1024); } while (0)
#define PG8_MMA(ai, bj, At, Bt) do { __builtin_amdgcn_s_setprio(1); _Pragma("unroll") for (int m = 0; m < 4; ++m) _Pragma("unroll") for (int n = 0; n < 2; ++n) _Pragma("unroll") for (int k = 0; k < 2; ++k) \
        acc[ai][bj][m][n] = __builtin_amdgcn_mfma_f32_16x16x32_bf16(Bt[n][k], At[m][k], acc[ai][bj][m][n], 0, 0, 0); __builtin_amdgcn_s_setprio(0); } while (0)
#define PG8_WAIT_V(n) asm volatile("s_waitcnt vmcnt(" #n ")" ::: "memory")
#define PG8_WAIT_L(n) asm volatile("s_waitcnt lgkmcnt(" #n ")" ::: "memory")
#define PG8_BAR __builtin_amdgcn_s_barrier()
#define PG8_SCHED __builtin_amdgcn_sched_barrier(0)
    Unit cur, nxt; int ui = 0;
    if (!S.next(0, cur)) return;
    f32x4 acc[2][2][4][2];
#pragma unroll
    for (int a = 0; a < 2; ++a)
#pragma unroll
        for (int b = 0; b < 2; ++b)
#pragma unroll
            for (int m = 0; m < 4; ++m)
#pragma unroll
                for (int n = 0; n < 2; ++n) acc[a][b][m][n] = (f32x4){0.f, 0.f, 0.f, 0.f};
    bf16x8 At[4][2], B0[2][2], B1[2][2];
    const char* cA = (const char*)g.A + (size_t)cur.pm * tstep + (size_t)cur.k0 * kstep; const char* cB = (const char*)g.Bt + (size_t)cur.pn * tstep + (size_t)cur.k0 * kstep;
    S.a_ready(cur);
    if constexpr (SP2) {
        PG8_STAGE(PG8_SB(0, 0), cB, voffB); PG8_STAGE(PG8_SB(0, 1), cB + hstep, voffB); PG8_STAGE(PG8_SA(0, 0), cA, voffA); PG8_STAGE(PG8_SA(0, 1), cA + hstep, voffA);
        if (wr == 1) PG8_BAR;
        PG8_WAIT_V(2); PG8_BAR;
        PG8_STAGE(PG8_SB(1, 0), cB + kstep, voffB); PG8_STAGE(PG8_SA(1, 0), cA + kstep, voffA); PG8_STAGE(PG8_SB(1, 1), cB + hstep + kstep, voffB);
        PG8_WAIT_V(6); PG8_BAR;
    } else {
        PG8_STAGE(PG8_SB(0, 0), cB, voffB); PG8_STAGE(PG8_SA(0, 0), cA, voffA); PG8_STAGE(PG8_SB(0, 1), cB + hstep, voffB); PG8_STAGE(PG8_SA(0, 1), cA + hstep, voffA);
        if (wr == 1) PG8_BAR;
        PG8_WAIT_V(4); PG8_BAR;
        PG8_STAGE(PG8_SB(1, 0), cB + kstep, voffB); PG8_STAGE(PG8_SA(1, 0), cA + kstep, voffA); PG8_STAGE(PG8_SB(1, 1), cB + hstep + kstep, voffB);
        PG8_WAIT_V(6); PG8_BAR;
    }
    for (;;) {
        const bool has_next = S.next(ui + 1, nxt);
        const char* nA = has_next ? (const char*)g.A + (size_t)nxt.pm * tstep + (size_t)nxt.k0 * kstep : cA; const char* nB = has_next ? (const char*)g.Bt + (size_t)nxt.pn * tstep + (size_t)nxt.k0 * kstep : cB;
        const int nt = cur.nk;
        for (int t = 0; t < nt; t += 2) {
            const bool last = (t == nt - 2);
            const char* a1 = cA + (size_t)(t + 1) * kstep;
            const char* a2 = last ? nA : cA + (size_t)(t + 2) * kstep; const char* b2 = last ? nB : cB + (size_t)(t + 2) * kstep;
            const char* a3 = a2 + kstep; const char* b3 = b2 + kstep;
            if (last && has_next) S.a_ready(nxt);
            if constexpr (SP2) {
            PG8_LDB(B0, 0, 0); PG8_LDB(B1, 0, 1); PG8_SCHED; PG8_LDA(At, 0, 0); PG8_STAGE(PG8_SA(1, 1), a1 + hstep, voffA);
            PG8_WAIT_V(8); PG8_WAIT_L(0); PG8_BAR; PG8_MMA(0, 0, At, B0); PG8_MMA(0, 1, At, B1); PG8_BAR; PG8_SCHED;
            PG8_LDA(At, 0, 1); PG8_STAGE(PG8_SB(0, 0), b2, voffB); PG8_STAGE(PG8_SB(0, 1), b2 + hstep, voffB); PG8_STAGE(PG8_SA(0, 0), a2, voffA);
            PG8_WAIT_V(8); PG8_WAIT_L(0); PG8_BAR; PG8_MMA(1, 0, At, B0); PG8_MMA(1, 1, At, B1); PG8_BAR; PG8_SCHED;
            PG8_LDB(B0, 1, 0); PG8_LDB(B1, 1, 1); PG8_SCHED; PG8_LDA(At, 1, 0); PG8_STAGE(PG8_SA(0, 1), a2 + hstep, voffA);
            PG8_WAIT_V(8); PG8_WAIT_L(0); PG8_BAR; PG8_MMA(0, 0, At, B0); PG8_MMA(0, 1, At, B1); PG8_BAR; PG8_SCHED;
            PG8_LDA(At, 1, 1); PG8_STAGE(PG8_SB(1, 0), b3, voffB); PG8_STAGE(PG8_SB(1, 1), b3 + hstep, voffB); PG8_STAGE(PG8_SA(1, 0), a3, voffA);
            PG8_WAIT_V(8); PG8_WAIT_L(0); PG8_BAR; PG8_MMA(1, 0, At, B0); PG8_MMA(1, 1, At, B1); PG8_BAR; PG8_SCHED;
            } else {
            PG8_LDB(B0, 0, 0); PG8_SCHED; PG8_LDA(At, 0, 0); PG8_STAGE(PG8_SA(1, 1), a1 + hstep, voffA);
            PG8_WAIT_L(8); PG8_BAR; PG8_WAIT_L(0); PG8_MMA(0, 0, At, B0); PG8_BAR; PG8_SCHED;
            PG8_LDB(B1, 0, 1); PG8_STAGE(PG8_SB(0, 0), b2, voffB);
            PG8_BAR; PG8_WAIT_L(0); PG8_MMA(0, 1, At, B1); PG8_BAR;
            PG8_LDA(At, 0, 1); PG8_STAGE(PG8_SA(0, 0), a2, voffA);
            PG8_BAR; PG8_WAIT_L(0); PG8_MMA(1, 0, At, B0); PG8_BAR; PG8_SCHED;
            PG8_STAGE(PG8_SB(0, 1), b2 + hstep, voffB);
            PG8_WAIT_V(6); PG8_BAR; PG8_MMA(1, 1, At, B1); PG8_BAR;
            PG8_LDB(B0, 1, 0); PG8_SCHED; PG8_LDA(At, 1, 0); PG8_STAGE(PG8_SA(0, 1), a2 + hstep, voffA);
            PG8_WAIT_L(8); PG8_BAR; PG8_WAIT_L(0); PG8_MMA(0, 0, At, B0); PG8_BAR; PG8_SCHED;
            PG8_LDB(B1, 1, 1); PG8_STAGE(PG8_SB(1, 0), b3, voffB);
            PG8_BAR; PG8_WAIT_L(0); PG8_MMA(0, 1, At, B1); PG8_BAR;
            PG8_LDA(At, 1, 1); PG8_STAGE(PG8_SA(1, 0), a3, voffA);
            PG8_BAR; PG8_WAIT_L(0); PG8_MMA(1, 0, At, B0); PG8_BAR; PG8_SCHED;
            PG8_STAGE(PG8_SB(1, 1), b3 + hstep, voffB);
            PG8_WAIT_V(6); PG8_BAR; PG8_MMA(1, 1, At, B1); PG8_BAR;
            }
        }
        if constexpr (ALIGN_EPI) { if (wr == 0) PG8_BAR; }
        if constexpr (!Epi::AFTER_DRAIN) { E(acc, cur, wr, wc, fr, fq); S.done(cur); }
        if (!has_next) break;
#pragma unroll
        for (int a = 0; a < 2; ++a)
#pragma unroll
            for (int b = 0; b < 2; ++b)
#pragma unroll
                for (int m = 0; m < 4; ++m)
#pragma unroll
                    for (int n = 0; n < 2; ++n) acc[a][b][m][n] = (f32x4){0.f, 0.f, 0.f, 0.f};
        cur = nxt; cA = nA; cB = nB; ++ui;
        if constexpr (ALIGN_EPI) { if (wr == 1) PG8_BAR; }
    }
    PG8_WAIT_V(0);
    if constexpr (!ALIGN_EPI) { if (wr == 0) PG8_BAR; }
    PG8_BAR;
#undef PG8_SA
#undef PG8_SB
#undef PG8_STAGE
#undef PG8_LDA
#undef PG8_LDB
#undef PG8_MMA
#undef PG8_WAIT_V
#undef PG8_WAIT_L
#undef PG8_BAR
#undef PG8_SCHED
}
}


#define XB_TMO      128
#define XB_XCNT(j)  (256  + 64 * (j))
#define XB_XSUB(j)  (1280 + 64 * (j))
#define XB_XGEN(j)  (2304 + 64 * (j))
#define XB_TOP      3328
#define XB_TOPGEN   3392
#define XCD_BAR_WORDS 3456
#define XB_SPIN_CAP (1u << 18)
__device__ __forceinline__ unsigned xb_ld(unsigned* p)              { return __hip_atomic_load(p, __ATOMIC_RELAXED, __HIP_MEMORY_SCOPE_AGENT); }
__device__ __forceinline__ unsigned xb_add(unsigned* p, unsigned v) { return __hip_atomic_fetch_add(p, v, __ATOMIC_RELAXED, __HIP_MEMORY_SCOPE_AGENT); }
__device__ __forceinline__ unsigned xb_xcc_id() { return (unsigned)__builtin_amdgcn_s_getreg((3 << 11) | 20) & 0xFu; }
#define XB_SPIN(cond, bar) do { unsigned _sp = 0; while (cond) { __builtin_amdgcn_s_sleep(1); \
    if ((++_sp & 255u) == 0u) { if (xb_ld(&(bar)[XB_TMO])) break; if (_sp > XB_SPIN_CAP) { atomicAdd(&(bar)[XB_TMO], 1u); break; } } } } while (0)
struct XcdBarrier { unsigned* bar; unsigned x; volatile LAS unsigned* st; };
__device__ __forceinline__ XcdBarrier xcd_barrier_post(unsigned* bar, volatile LAS unsigned* st) {
    XcdBarrier b; b.bar = bar; b.x = xb_xcc_id(); b.st = st;
    if (threadIdx.x == 0) (void)xb_add(&bar[XB_XCNT(b.x)], 1u);
    return b;
}
__device__ __forceinline__ void xcd_barrier_complete(unsigned* bar, unsigned x, unsigned& nloc, unsigned& nx) {
    const unsigned G = gridDim.x * gridDim.y * gridDim.z;
    unsigned sum, cnt, mine, sp = 0u;
    for (;;) {
        sum = 0u; cnt = 0u; mine = 0u;
#pragma unroll
        for (unsigned j = 0; j < 16; ++j) { const unsigned c = xb_ld(&bar[XB_XCNT(j)]); sum += c; cnt += (c > 0u) ? 1u : 0u; mine = (j == x) ? c : mine; }
        if (sum == G) break;
        __builtin_amdgcn_s_sleep(1);
        if ((++sp & 255u) == 0u) { if (xb_ld(&bar[XB_TMO])) break; if (sp > XB_SPIN_CAP) { atomicAdd(&bar[XB_TMO], 1u); break; } }
    }
    nloc = mine > 0u ? mine : 1u; nx = cnt > 0u ? cnt : 1u;
}
__device__ __forceinline__ void xcd_barrier(const XcdBarrier& b) {
    asm volatile("s_waitcnt vmcnt(0)" ::: "memory");
    __syncthreads();
    if (threadIdx.x == 0) {
        unsigned* bar = b.bar;
        __builtin_amdgcn_s_waitcnt(0);
        unsigned nloc = b.st[0], nx = b.st[1];
        if (nloc == 0u) { xcd_barrier_complete(bar, b.x, nloc, nx); b.st[0] = nloc; b.st[1] = nx; }
        const unsigned old = xb_add(&bar[XB_XSUB(b.x)], 1u);
        const unsigned gen = old / nloc;
        if (old + 1u == (gen + 1u) * nloc) {
            __builtin_amdgcn_fence(__ATOMIC_RELEASE, "agent");
            asm volatile("s_waitcnt vmcnt(0)" ::: "memory");
            const unsigned og = xb_add(&bar[XB_TOP], 1u);
            const unsigned tg = og / nx;
            if (og + 1u == (tg + 1u) * nx) xb_add(&bar[XB_TOPGEN], 1u);
            else XB_SPIN(xb_ld(&bar[XB_TOPGEN]) == tg, bar);
            __builtin_amdgcn_fence(__ATOMIC_ACQUIRE, "agent");
            xb_add(&bar[XB_XGEN(b.x)], 1u);
            asm volatile("s_waitcnt vmcnt(0)" ::: "memory");
        } else {
            XB_SPIN(xb_ld(&bar[XB_XGEN(b.x)]) == gen, bar);
            __builtin_amdgcn_fence(__ATOMIC_ACQUIRE, "agent");
            asm volatile("s_waitcnt vmcnt(0)" ::: "memory");
        }
    }
    __syncthreads();
}

struct Args { const float* in[19]; float* out; unsigned char* ws; int ph_lo, ph_hi; };
enum { I_X = 0, I_C, I_CTX, I_CCTX, I_WMOD, I_BMOD, I_NPRE, I_NPOST, I_WG, I_WU, I_WD, I_WIN, I_WOUT, I_VGAIN, I_WS, I_BS, I_LAM, I_SUBLN, I_SINK };

#define LDS_WAIT() asm volatile("s_waitcnt lgkmcnt(0)" ::: "memory")

__device__ __forceinline__ void transpose_item(const float* __restrict__ W, int N, int k0, int n0, bf16_t* __restrict__ WT, int K, int drow0, LAS float* scr, int lane, float wscale = 1.0f) {
#pragma unroll 8
    for (int i = 0; i < 32; ++i) { const int kk = 2 * i + (lane >> 5); scr[kk * 33 + (lane & 31)] = __builtin_nontemporal_load(W + (size_t)(k0 + kk) * N + n0 + (lane & 31)); }
    LDS_WAIT(); asm volatile("" ::: "memory");
    const int c = lane & 7;
#pragma unroll
    for (int j = 0; j < 4; ++j) { const int n = (lane >> 3) + 8 * j; const LAS float* s = scr + (8 * c) * 33 + n;
        u32x4 o; o.x = cvt_pk_bf16(s[0 * 33] * wscale, s[1 * 33] * wscale); o.y = cvt_pk_bf16(s[2 * 33] * wscale, s[3 * 33] * wscale); o.z = cvt_pk_bf16(s[4 * 33] * wscale, s[5 * 33] * wscale); o.w = cvt_pk_bf16(s[6 * 33] * wscale, s[7 * 33] * wscale);
        __builtin_nontemporal_store(o, (u32x4*)(WT + (size_t)(drow0 + n0 + n) * K + k0 + 8 * c)); }
    LDS_WAIT(); asm volatile("" ::: "memory");
}

__device__ __forceinline__ void prologue_a(const Args& a, LAS unsigned char* lds, int tid, int G) {
    const int lane = tid & 63, wave = tid >> 6;
    unsigned char* ws = a.ws;
    {
        LAS float* scr = (LAS float*)(lds + wave * 16384);
        const int gw = blockIdx.x * 8 + wave, NGW = G * 8;
        constexpr int PER_L = 10240;
        for (int it = gw; it < DEPTH * PER_L; it += NGW) {
            const int l = it / PER_L; int r = it % PER_L;
            if (r < 5632) {
                const int up = r >= 2816; if (up) r -= 2816;
                const int sub = r / 1408, rr = r % 1408, kb = rr / 88, nb = rr % 88, n0 = nb * 32;
                const float* W = a.in[up ? I_WU : I_WG] + (size_t)(l * 2 + sub) * DM * DFF;
                bf16_t* WT = (bf16_t*)(ws + WS_WGU) + (size_t)(l * 2 + sub) * NGU * DM;
                transpose_item(W, DFF, kb * 64, n0, WT, DM, 256 * (n0 >> 7) + (up ? 128 : 0) + (n0 & 127) - n0, scr, lane, up ? (1.0f / LOG2E) : LOG2E);
            } else if (r < 8448) {
                r -= 5632; const int sub = r / 1408, rr = r % 1408, kb = rr / 32, nb = rr % 32;
                const float* W = a.in[I_WD] + (size_t)(l * 2 + sub) * DFF * DM;
                bf16_t* WT = (bf16_t*)(ws + WS_WD) + (size_t)(l * 2 + sub) * DM * DFF;
                transpose_item(W, DM, kb * 64, nb * 32, WT, DFF, 0, scr, lane);
            } else if (r < 9728) {
                r -= 8448; const int kb = r / 80, nb = r % 80;
                transpose_item(a.in[I_WIN] + (size_t)l * DM * INC, INC, kb * 64, nb * 32, (bf16_t*)(ws + WS_WIN) + (size_t)l * INC * DM, DM, 0, scr, lane);
            } else {
                r -= 9728; const int kb = r / 32, nb = r % 32;
                transpose_item(a.in[I_WOUT] + (size_t)l * DM * DM, DM, kb * 64, nb * 32, (bf16_t*)(ws + WS_WOUT) + (size_t)l * DM * DM, DM, 0, scr, lane);
            }
        }
        const float* wsrc = a.in[I_WS]; bf16_t* wdst = (bf16_t*)(ws + WS_WS);
        for (int i = (blockIdx.x * 512 + tid); i < DEPTH * 4 * 128 * 128 / 8; i += G * 512) {
            const f32x4 v0 = *(const f32x4*)(wsrc + (size_t)i * 8), v1 = *(const f32x4*)(wsrc + (size_t)i * 8 + 4);
            *(u32x4*)(wdst + (size_t)i * 8) = (u32x4){cvt_pk_bf16(v0[0], v0[1]), cvt_pk_bf16(v0[2], v0[3]), cvt_pk_bf16(v1[0], v1[1]), cvt_pk_bf16(v1[2], v1[3])};
        }
    }
    __syncthreads();
    {
        LAS float* sc = (LAS float*)lds;
        LAS float* red = (LAS float*)(lds + 9 * 1024 * 4);
        for (int i = tid; i < 9 * 1024; i += 512) { const int m = i >> 10, k = i & 1023; const float v = (m < 8) ? a.in[I_C][m * 1024 + k] : a.in[I_CCTX][k]; sc[i] = silu_f(v); }
        __syncthreads();
        float* MOD = (float*)(ws + WS_MOD);
        const int kq = tid >> 7, jj = tid & 127;
        for (int it = blockIdx.x; it < DEPTH * 72; it += G) {
            const int l = it / 72, cb = it % 72, col = cb * 128 + jj;
            const float* wp = a.in[I_WMOD] + (size_t)l * DM * 9216 + col;
            float acc[9];
#pragma unroll
            for (int m = 0; m < 9; ++m) acc[m] = 0.f;
#pragma unroll 4
            for (int k = kq * 256; k < kq * 256 + 256; ++k) {
                const float w = __builtin_nontemporal_load(wp + (size_t)k * 9216);
#pragma unroll
                for (int m = 0; m < 9; ++m) acc[m] += sc[m * 1024 + k] * w;
            }
#pragma unroll
            for (int m = 0; m < 9; ++m) red[(kq * 9 + m) * 128 + jj] = acc[m];
            __syncthreads();
            for (int o = tid; o < 9 * 128; o += 512) { const int m = o >> 7, j2 = o & 127;
                const float v = red[(0 * 9 + m) * 128 + j2] + red[(1 * 9 + m) * 128 + j2] + red[(2 * 9 + m) * 128 + j2] + red[(3 * 9 + m) * 128 + j2];
                MOD[((size_t)l * 9 + m) * 9216 + cb * 128 + j2] = v + a.in[I_BMOD][l * 9216 + cb * 128 + j2]; }
            __syncthreads();
        }
    }
    if (blockIdx.x == 0) {
        f32x2* rope = (f32x2*)(ws + WS_ROPE);
        for (int i = tid; i < 64 * 16; i += 512) { const int pos = i >> 4, j = i & 15; const float inv = powf(10000.0f, -(float)j / 16.0f); const float ang = (float)pos * inv; rope[i] = (f32x2){cosf(ang), sinf(ang)}; }
    }
    if (blockIdx.x == (G > 1 ? 1 : 0) && wave == 0) {
        float* LAM = (float*)(ws + WS_LAM);
        for (int l = 0; l < DEPTH; ++l) {
            const float* lp = a.in[I_LAM] + l * 256;
            const float s1 = wave_sum(lp[lane] * lp[64 + lane]), s2 = wave_sum(lp[128 + lane] * lp[192 + lane]);
            const float lam_init = 0.8f - 0.6f * expf(-0.3f * (float)l);
            if (lane == 0) { LAM[l] = expf(s1) - expf(s2) + lam_init; LAM[4 + l] = 1.0f - lam_init; }
        }
    }
}

__device__ __forceinline__ void unpack8(const u32x4 w, f32x4& lo, f32x4& hi) {
    lo = (f32x4){__uint_as_float(w.x << 16), __uint_as_float(w.x & 0xffff0000u), __uint_as_float(w.y << 16), __uint_as_float(w.y & 0xffff0000u)};
    hi = (f32x4){__uint_as_float(w.z << 16), __uint_as_float(w.z & 0xffff0000u), __uint_as_float(w.w << 16), __uint_as_float(w.w & 0xffff0000u)};
}
__device__ __forceinline__ void norm_phase(const Args& a, int l, int j, int l2, int j2, int nrows, float wgt, int tid, int G) {
    const int lane = tid & 63, wave = tid >> 6;
    unsigned char* ws = a.ws;
    const float* MOD = (const float*)(ws + WS_MOD);
    const bf16_t* Z = (const bf16_t*)(ws + WS_Z);
    bf16_t* S16 = (bf16_t*)(ws + WS_S16);
    bf16_t* Y = (bf16_t*)(ws + WS_Y);
    const int NW = G * 8, gw = blockIdx.x * 8 + wave;
    const int lc = (T_LAT + NW - 1) / NW, cc = (nrows > T_LAT) ? (nrows - T_LAT + NW - 1) / NW : 0;
    const int la = gw * lc < T_LAT ? gw * lc : T_LAT, lb = (la + lc < T_LAT) ? la + lc : T_LAT;
    const int ca0 = T_LAT + gw * cc, ca = ca0 < nrows ? ca0 : nrows, cb = (ca + cc < nrows) ? ca + cc : nrows;
    const int nmine = (lb - la) + (cb - ca);
#define NORM_ROW(i_) ((i_) < lb - la ? la + (i_) : ca + ((i_) - (lb - la)))
    const int cl = 8 * lane;
    const bool final_out = (l2 >= DEPTH);
    int mcur = -1;
    f32x4 Av[4], Bv[4], Cv[4];
#pragma unroll
    for (int k = 0; k < 4; ++k) { Av[k] = (f32x4){0.f, 0.f, 0.f, 0.f}; Bv[k] = Av[k]; Cv[k] = Av[k]; }
    u32x4 zc0 = (u32x4){0u, 0u, 0u, 0u}, zc1 = zc0, qc0 = zc0, qc1 = zc0; f32x4 xc[4];
#pragma unroll
    for (int k = 0; k < 4; ++k) xc[k] = (f32x4){0.f, 0.f, 0.f, 0.f};
#define NORM_LOAD(row_, z0_, z1_, q0_, q1_, x_) do { \
        if (l < 0) { const float* src_ = ((row_) < T_LAT) ? a.in[I_X] + (size_t)(row_) * DM : a.in[I_CTX] + (size_t)((row_) - T_LAT) * DM; \
            _Pragma("unroll") for (int k = 0; k < 4; ++k) x_[k] = __builtin_nontemporal_load((const f32x4*)(src_ + 512 * (k >> 1) + cl + 4 * (k & 1))); } \
        else { z0_ = __builtin_nontemporal_load((const u32x4*)(Z + (size_t)(row_) * DM + cl)); z1_ = __builtin_nontemporal_load((const u32x4*)(Z + (size_t)(row_) * DM + 512 + cl)); \
            q0_ = __builtin_nontemporal_load((const u32x4*)(S16 + (size_t)(row_) * DM + cl)); q1_ = __builtin_nontemporal_load((const u32x4*)(S16 + (size_t)(row_) * DM + 512 + cl)); } } while (0)
    if (nmine > 0) NORM_LOAD(NORM_ROW(0), zc0, zc1, qc0, qc1, xc);
    for (int ri = 0; ri < nmine; ++ri) {
        const int row = NORM_ROW(ri);
        const bool lat = row < T_LAT;
        const int m = lat ? (row >> 11) : 8;
        u32x4 zn0 = zc0, zn1 = zc1, qn0 = qc0, qn1 = qc1; f32x4 xn[4];
#pragma unroll
        for (int k = 0; k < 4; ++k) xn[k] = xc[k];
        if (ri + 1 < nmine) { const int rown = NORM_ROW(ri + 1); NORM_LOAD(rown, zn0, zn1, qn0, qn1, xn); }
        if (m != mcur) {
            mcur = m;
            if (l >= 0) {
                const float* gate = MOD + ((size_t)l * 9 + m) * 9216 + (3 * j + 2) * DM;
                const float* post = a.in[I_NPOST] + (size_t)(l * 3 + j) * DM;
#pragma unroll
                for (int k = 0; k < 4; ++k) { const int c = 512 * (k >> 1) + cl + 4 * (k & 1); Av[k] = *(const f32x4*)(gate + c) * *(const f32x4*)(post + c) * wgt; }
            }
            if (l2 < DEPTH) {
                const float* shift = MOD + ((size_t)l2 * 9 + m) * 9216 + (3 * j2) * DM;
                const float* scale = shift + DM;
                const float* pre = a.in[I_NPRE] + (size_t)(l2 * 3 + j2) * DM;
#pragma unroll
                for (int k = 0; k < 4; ++k) { const int c = 512 * (k >> 1) + cl + 4 * (k & 1); Bv[k] = *(const f32x4*)(pre + c) * (*(const f32x4*)(scale + c) + 1.0f); Cv[k] = *(const f32x4*)(shift + c); }
            }
        }
        f32x4 sv[4];
        if (l < 0) {
#pragma unroll
            for (int k = 0; k < 4; ++k) sv[k] = xc[k];
        } else {
            unpack8(qc0, sv[0], sv[1]); unpack8(qc1, sv[2], sv[3]);
            f32x4 zv[4];
            unpack8(zc0, zv[0], zv[1]); unpack8(zc1, zv[2], zv[3]);
            if (!lat) {
#pragma unroll
                for (int pp = 1; pp < 8; ++pp) { const bf16_t* zp = Z + (size_t)(row + pp * T_CTX) * DM + cl; f32x4 t0, t1, t2, t3;
                    unpack8(*(const u32x4*)zp, t0, t1); unpack8(*(const u32x4*)(zp + 512), t2, t3); zv[0] += t0; zv[1] += t1; zv[2] += t2; zv[3] += t3; }
            }
            float ss = 0.f;
#pragma unroll
            for (int k = 0; k < 4; ++k) ss += (zv[k][0] * zv[k][0] + zv[k][1] * zv[k][1]) + (zv[k][2] * zv[k][2] + zv[k][3] * zv[k][3]);
            ss = wave_sum(ss);
            const float rstd = rsqrtf(ss * (1.0f / DM) + EPSV);
#pragma unroll
            for (int k = 0; k < 4; ++k) sv[k] += Av[k] * (zv[k] * rstd);
        }
        if (final_out) {
            float* orow = a.out + (size_t)row * DM;
#pragma unroll
            for (int k = 0; k < 4; ++k) *(f32x4*)(orow + 512 * (k >> 1) + cl + 4 * (k & 1)) = sv[k];
        } else {
            __builtin_nontemporal_store((u32x4){cvt_pk_bf16(sv[0][0], sv[0][1]), cvt_pk_bf16(sv[0][2], sv[0][3]), cvt_pk_bf16(sv[1][0], sv[1][1]), cvt_pk_bf16(sv[1][2], sv[1][3])}, (u32x4*)(S16 + (size_t)row * DM + cl));
            __builtin_nontemporal_store((u32x4){cvt_pk_bf16(sv[2][0], sv[2][1]), cvt_pk_bf16(sv[2][2], sv[2][3]), cvt_pk_bf16(sv[3][0], sv[3][1]), cvt_pk_bf16(sv[3][2], sv[3][3])}, (u32x4*)(S16 + (size_t)row * DM + 512 + cl));
        }
        if (l2 < DEPTH) {
            float ss = 0.f;
#pragma unroll
            for (int k = 0; k < 4; ++k) ss += (sv[k][0] * sv[k][0] + sv[k][1] * sv[k][1]) + (sv[k][2] * sv[k][2] + sv[k][3] * sv[k][3]);
            ss = wave_sum(ss);
            const float rstd = rsqrtf(ss * (1.0f / DM) + EPSV);
            f32x4 y[4];
#pragma unroll
            for (int k = 0; k < 4; ++k) y[k] = (sv[k] * rstd) * Bv[k] + Cv[k];
            *(u32x4*)(Y + (size_t)row * DM + cl) = (u32x4){cvt_pk_bf16(y[0][0], y[0][1]), cvt_pk_bf16(y[0][2], y[0][3]), cvt_pk_bf16(y[1][0], y[1][1]), cvt_pk_bf16(y[1][2], y[1][3])};
            *(u32x4*)(Y + (size_t)row * DM + 512 + cl) = (u32x4){cvt_pk_bf16(y[2][0], y[2][1]), cvt_pk_bf16(y[2][2], y[2][3]), cvt_pk_bf16(y[3][0], y[3][1]), cvt_pk_bf16(y[3][2], y[3][3])};
        }
        zc0 = zn0; zc1 = zn1; qc0 = qn0; qc1 = qn1;
#pragma unroll
        for (int k = 0; k < 4; ++k) xc[k] = xn[k];
    }
#undef NORM_LOAD
#undef NORM_ROW
}

template <int NMAP, int VD, bool SWA>
__device__ __forceinline__ void attn_unit(LAS unsigned char* lds, const bf16_t* __restrict__ Qp, int qpitch, const bf16_t* __restrict__ Kb, const bf16_t* __restrict__ Vt,
                                          int n0, int t1lo, int t1hi, int qp0, float sink_l2, float lam, const float* __restrict__ gsub, float post_scale, bf16_t* __restrict__ Op, int tid) {
    constexpr int KW = SWA ? 64 : 64 * NMAP, KMS = SWA ? 0 : 64, KP = 144, VP = 144, NKC = KW / 64, NVC = VD / 64, NET = VD / 16;
    constexpr int KBYTES = 64 * KP * 2, BUFB = KBYTES + 64 * VP * 2;
    const int lane = tid & 63, w = tid >> 6, fr = lane & 15, fq = lane >> 4;
    bf16x8 qf[NMAP][2];
    { const bf16_t* qr = Qp + (size_t)(16 * w + fr) * qpitch + fq * 8;
#pragma unroll
      for (int mp = 0; mp < NMAP; ++mp)
#pragma unroll
          for (int ks = 0; ks < 2; ++ks) qf[mp][ks] = *(const bf16x8*)(qr + mp * 64 + ks * 32); }
    f32x4 oacc[NMAP][NET], negm[NMAP]; float mrun[NMAP], lsum[NMAP];
#pragma unroll
    for (int mp = 0; mp < NMAP; ++mp) { mrun[mp] = 0.f; lsum[mp] = 0.f; negm[mp] = (f32x4){0.f, 0.f, 0.f, 0.f};
#pragma unroll
        for (int et = 0; et < NET; ++et) oacc[mp][et] = (f32x4){0.f, 0.f, 0.f, 0.f}; }
    const int ntiles = n0 + (t1hi - t1lo);
    u32x4 kreg[NKC], vreg[NVC];
#define ATT_TILE(i) ((i) < n0 ? (i) : t1lo + ((i) - n0))
#define ATT_LOAD(tile) do { const int k0_ = (tile) * 64; \
        _Pragma("unroll") for (int i_ = 0; i_ < NKC; ++i_) { const int c_ = tid + 512 * i_, key_ = c_ / (KW / 8), cc_ = c_ % (KW / 8); kreg[i_] = *(const u32x4*)(Kb + (size_t)(k0_ + key_) * KW + cc_ * 8); } \
        _Pragma("unroll") for (int i_ = 0; i_ < NVC; ++i_) { const int c_ = tid + 512 * i_, key_ = c_ / (VD / 8), cc_ = c_ % (VD / 8); vreg[i_] = *(const u32x4*)(Vt + (size_t)(k0_ + key_) * VD + cc_ * 8); } } while (0)
#define ATT_STORE(buf) do { LAS bf16_t* kS_ = (LAS bf16_t*)(lds + (buf) * BUFB); LAS bf16_t* vS_ = (LAS bf16_t*)(lds + (buf) * BUFB + KBYTES); \
        _Pragma("unroll") for (int i_ = 0; i_ < NKC; ++i_) { const int c_ = tid + 512 * i_, key_ = c_ / (KW / 8), cc_ = c_ % (KW / 8); *(LAS u32x4*)(kS_ + key_ * KP + cc_ * 8) = kreg[i_]; } \
        _Pragma("unroll") for (int i_ = 0; i_ < NVC; ++i_) { const int c_ = tid + 512 * i_, key_ = c_ / (VD / 8), cc_ = c_ % (VD / 8); *(LAS u32x4*)(vS_ + key_ * VP + cc_ * 8) = vreg[i_]; } } while (0)
    ATT_LOAD(ATT_TILE(0));
    ATT_STORE(0);
    if (ntiles > 1) ATT_LOAD(ATT_TILE(1));
    __syncthreads();
    for (int i = 0; i < ntiles; ++i) {
        const int t = ATT_TILE(i);
        if (i + 1 < ntiles) { ATT_STORE((i + 1) & 1); if (i + 2 < ntiles) ATT_LOAD(ATT_TILE(i + 2)); }
        const LAS bf16_t* kS = (const LAS bf16_t*)(lds + (i & 1) * BUFB);
        const LAS bf16_t* vS = (const LAS bf16_t*)(lds + (i & 1) * BUFB + KBYTES);
        bf16x8 pf[NMAP][2];
        f32x4 sacc[NMAP][4];
#pragma unroll
        for (int mp = 0; mp < NMAP; ++mp) {
            bf16x8 kf[4][2];
#pragma unroll
            for (int kt = 0; kt < 4; ++kt)
#pragma unroll
                for (int ks = 0; ks < 2; ++ks) kf[kt][ks] = *(const LAS bf16x8*)(kS + (16 * kt + fr) * KP + mp * KMS + ks * 32 + fq * 8);
            __builtin_amdgcn_sched_barrier(0);
#pragma unroll
            for (int kt = 0; kt < 4; ++kt) sacc[mp][kt] = __builtin_amdgcn_mfma_f32_16x16x32_bf16(kf[kt][0], qf[mp][0], negm[mp], 0, 0, 0);
#pragma unroll
            for (int kt = 0; kt < 4; ++kt) sacc[mp][kt] = __builtin_amdgcn_mfma_f32_16x16x32_bf16(kf[kt][1], qf[mp][1], sacc[mp][kt], 0, 0, 0);
        }
        bf16x8 va[4];
#define ATT_LDV(dst, idx) do { const LAS bf16_t* vp_ = vS + (32 * ((idx) / NET) + 4 * fq + (fr >> 2)) * VP + 16 * ((idx) % NET) + 4 * (fr & 3); \
            const s16x4 lo_ = __builtin_amdgcn_ds_read_tr16_b64_v4i16((LAS s16x4*)vp_), hi_ = __builtin_amdgcn_ds_read_tr16_b64_v4i16((LAS s16x4*)(vp_ + 16 * VP)); \
            dst = (bf16x8){lo_[0], lo_[1], lo_[2], lo_[3], hi_[0], hi_[1], hi_[2], hi_[3]}; } while (0)
#pragma unroll
        for (int i2 = 0; i2 < 4; ++i2) ATT_LDV(va[i2], i2);
        if (SWA && t >= 4) {
            const int dq = qp0 + 16 * w + fr - (64 * (t - 4) + 4 * fq);
#pragma unroll
            for (int kt = 0; kt < 4; ++kt)
#pragma unroll
                for (int r = 0; r < 4; ++r) { const int d = dq - 16 * kt - r; if (d > 128 || d < -128) {
#pragma unroll
                    for (int mp = 0; mp < NMAP; ++mp) sacc[mp][kt][r] = -INFINITY; } }
        }
        float mx[NMAP];
#pragma unroll
        for (int mp = 0; mp < NMAP; ++mp) {
            float v = fmax2(fmax2(sacc[mp][0][0], sacc[mp][0][1]), fmax2(sacc[mp][0][2], sacc[mp][0][3]));
#pragma unroll
            for (int kt = 1; kt < 4; ++kt) v = fmax2(v, fmax2(fmax2(sacc[mp][kt][0], sacc[mp][kt][1]), fmax2(sacc[mp][kt][2], sacc[mp][kt][3])));
            mx[mp] = v;
        }
#pragma unroll
        for (int mp = 0; mp < NMAP; ++mp) mx[mp] = fmax2(mx[mp], __shfl_xor(mx[mp], 16));
#pragma unroll
        for (int mp = 0; mp < NMAP; ++mp) mx[mp] = fmax2(mx[mp], __shfl_xor(mx[mp], 32));
#pragma unroll
        for (int mp = 0; mp < NMAP; ++mp) {
            if (i == 0 || __builtin_amdgcn_ballot_w64(mx[mp] > 8.0f) != 0ull) {
                const float delta = (i == 0) ? mx[mp] : fmaxf(mx[mp], 0.f), alpha = (i == 0) ? 0.f : __builtin_amdgcn_exp2f(-delta);
                mrun[mp] += delta; negm[mp] = (f32x4){-mrun[mp], -mrun[mp], -mrun[mp], -mrun[mp]}; lsum[mp] *= alpha;
#pragma unroll
                for (int kt = 0; kt < 4; ++kt) sacc[mp][kt] = sacc[mp][kt] - delta;
#pragma unroll
                for (int et = 0; et < NET; ++et) oacc[mp][et] = oacc[mp][et] * alpha;
            }
            float ps = 0.f;
#pragma unroll
            for (int kt = 0; kt < 4; ++kt)
#pragma unroll
                for (int r = 0; r < 4; ++r) { const float p = __builtin_amdgcn_exp2f(sacc[mp][kt][r]); sacc[mp][kt][r] = p; ps += p; }
            lsum[mp] += ps;
#pragma unroll
            for (int s2 = 0; s2 < 2; ++s2) {
                u32x4 pk; pk.x = cvt_pk_bf16(sacc[mp][2 * s2][0], sacc[mp][2 * s2][1]); pk.y = cvt_pk_bf16(sacc[mp][2 * s2][2], sacc[mp][2 * s2][3]);
                pk.z = cvt_pk_bf16(sacc[mp][2 * s2 + 1][0], sacc[mp][2 * s2 + 1][1]); pk.w = cvt_pk_bf16(sacc[mp][2 * s2 + 1][2], sacc[mp][2 * s2 + 1][3]);
                pf[mp][s2] = __builtin_bit_cast(bf16x8, pk);
            }
        }
#pragma unroll
        for (int idx = 0; idx < 2 * NET; ++idx) {
            const int et = idx % NET, s2 = idx / NET;
            const bf16x8 cur = va[idx & 3];
            if (idx + 4 < 2 * NET) ATT_LDV(va[idx & 3], idx + 4);
#pragma unroll
            for (int mp = 0; mp < NMAP; ++mp) oacc[mp][et] = __builtin_amdgcn_mfma_f32_16x16x32_bf16(cur, pf[mp][s2], oacc[mp][et], 0, 0, 0);
        }
#undef ATT_LDV
        __syncthreads();
    }
#undef ATT_TILE
#undef ATT_LOAD
#undef ATT_STORE
    float lt[NMAP];
#pragma unroll
    for (int mp = 0; mp < NMAP; ++mp) { float v = lsum[mp]; v += __shfl_xor(v, 16); v += __shfl_xor(v, 32); lt[mp] = v; }
    bf16_t* orow = Op + (size_t)(16 * w + fr) * DM + 4 * fq;
    if constexpr (!SWA) {
        const float inv0 = 1.0f / lt[0], inv1 = lam / lt[1];
        float ss = 0.f;
#pragma unroll
        for (int et = 0; et < NET; ++et)
#pragma unroll
            for (int r = 0; r < 4; ++r) { const float o = oacc[0][et][r] * inv0 - oacc[1][et][r] * inv1; oacc[0][et][r] = o; ss += o * o; }
        ss += __shfl_xor(ss, 16); ss += __shfl_xor(ss, 32);
        const float rstd = rsqrtf(ss * (1.0f / VD) + EPSV) * post_scale;
#pragma unroll
        for (int et = 0; et < NET; ++et) { const f32x4 g = *(const f32x4*)(gsub + 16 * et + 4 * fq); const f32x4 v = oacc[0][et] * rstd * g;
            *(u32x2*)(orow + 16 * et) = (u32x2){cvt_pk_bf16(v[0], v[1]), cvt_pk_bf16(v[2], v[3])}; }
    } else {
#pragma unroll
        for (int mp = 0; mp < NMAP; ++mp) {
            const float l0 = lt[mp] + __builtin_amdgcn_exp2f((mp == 0 ? sink_l2 : lam) - mrun[mp]);
            const float inv = 1.0f / l0;
#pragma unroll
            for (int et = 0; et < NET; ++et) { const f32x4 v = oacc[mp][et] * inv; *(u32x2*)(orow + mp * 64 + 16 * et) = (u32x2){cvt_pk_bf16(v[0], v[1]), cvt_pk_bf16(v[2], v[3])}; }
        }
    }
    __syncthreads();
}

__device__ __forceinline__ void gmlp_unit(LAS unsigned char* lds, const bf16_t* __restrict__ UV, const bf16_t* __restrict__ Wsb  , const float* __restrict__ gain  ,
                                          const float* __restrict__ bs  , int r0, int h, bf16_t* __restrict__ O, int tid) {
    constexpr int VP = 136;
    LAS bf16_t* vT = (LAS bf16_t*)lds;
    const int lane = tid & 63, w = tid >> 6, fr = lane & 15, fq = lane >> 4;
    {
        const int q = tid >> 2, part = tid & 3;
        const bf16_t* src = UV + (size_t)(r0 + q) * 512 + 256 + 64 * h + 16 * part;
        const u32x4 a0 = *(const u32x4*)src, a1 = *(const u32x4*)(src + 8);
        float v[16];
#pragma unroll
        for (int i = 0; i < 4; ++i) { v[2 * i] = __uint_as_float(a0[i] << 16); v[2 * i + 1] = __uint_as_float(a0[i] & 0xffff0000u); v[8 + 2 * i] = __uint_as_float(a1[i] << 16); v[8 + 2 * i + 1] = __uint_as_float(a1[i] & 0xffff0000u); }
        float ss = 0.f;
#pragma unroll
        for (int i = 0; i < 16; ++i) ss += v[i] * v[i];
        ss += __shfl_xor(ss, 1); ss += __shfl_xor(ss, 2);
        const float rstd = rsqrtf(ss * (1.0f / 64.0f) + EPSV);
#pragma unroll
        for (int i = 0; i < 16; ++i) { const int c = 16 * part + i; vT[c * VP + q] = (bf16_t)(cvt_pk_bf16(v[i] * rstd * gain[c], 0.f) & 0xffffu); }
    }
    __syncthreads();
    f32x4 acc[4];
#pragma unroll
    for (int nt = 0; nt < 4; ++nt) acc[nt] = (f32x4){0.f, 0.f, 0.f, 0.f};
#pragma unroll
    for (int ks = 0; ks < 4; ++ks) {
        const bf16x8 wf = *(const bf16x8*)(Wsb + (size_t)(16 * w + fr) * 128 + 32 * ks + 8 * fq);
#pragma unroll
        for (int nt = 0; nt < 4; ++nt) { const bf16x8 vf = *(const LAS bf16x8*)(vT + (16 * nt + fr) * VP + 32 * ks + 8 * fq);
            acc[nt] = __builtin_amdgcn_mfma_f32_16x16x32_bf16(vf, wf, acc[nt], 0, 0, 0); }
    }
    const int p = 16 * w + fr; const float bias = bs[p];
    const bf16_t* up = UV + (size_t)(r0 + p) * 512 + 64 * h + 4 * fq;
    bf16_t* op = O + (size_t)(r0 + p) * DM + 64 * h + 4 * fq;
#pragma unroll
    for (int nt = 0; nt < 4; ++nt) {
        const u32x2 uu = *(const u32x2*)(up + 16 * nt);
        const float u0 = __uint_as_float(uu.x << 16), u1 = __uint_as_float(uu.x & 0xffff0000u), u2 = __uint_as_float(uu.y << 16), u3 = __uint_as_float(uu.y & 0xffff0000u);
        *(u32x2*)(op + 16 * nt) = (u32x2){cvt_pk_bf16(u0 * (acc[nt][0] + bias), u1 * (acc[nt][1] + bias)), cvt_pk_bf16(u2 * (acc[nt][2] + bias), u3 * (acc[nt][3] + bias))};
    }
    __syncthreads();
}

__device__ __forceinline__ void mix_phase(const Args& a, LAS unsigned char* lds, int l, int tid_in, int G) {
    unsigned char* ws = a.ws;
    const bool last = (l == DEPTH - 1);
    const bf16_t* UV = (const bf16_t*)(ws + R1_UV); const bf16_t* QB = (const bf16_t*)(ws + R1_QB); const bf16_t* QC = (const bf16_t*)(ws + R1_QC);
    const bf16_t* KB = (const bf16_t*)(ws + R1_KB); const bf16_t* VBt = (const bf16_t*)(ws + R1_VB); const bf16_t* KC = (const bf16_t*)(ws + R1_KC); const bf16_t* VCt = (const bf16_t*)(ws + R1_VC);
    bf16_t* O = (bf16_t*)(ws + R1_O);
    const float* LAM = (const float*)(ws + WS_LAM);
    const float lam = LAM[l], post_scale = LAM[4 + l];
    const float* gsub = a.in[I_SUBLN] + l * 128;
    const int n_ctxd = last ? 0 : 64, n_ctxs = last ? 0 : 32, n_g = last ? 512 : 576;
    const int e0 = 512, e1 = e0 + 256, e2 = e1 + n_ctxd, e3 = e2 + n_ctxs, e4 = e3 + n_g;
    for (int u = blockIdx.x; u < e4; u += G) {
        int tid = tid_in; asm volatile("" : "+v"(tid));
        if (u < e3) {
            const bool is_swa = (u >= e0 && u < e1) || (u >= e2);
            const bool is_ctx = (u >= e1);
            int b, hh, qb, row0;
            if (u < e0) {
                const int v = u, x = v & 7, slot = (v >> 3) & 31, rnd = v >> 8, P = x * 4 + rnd * 2 + (slot >> 4);
                b = P >> 2; hh = P & 3; qb = slot & 15; row0 = b * SEQ + 128 * qb; }
            else if (u < e1) { const int v = u - e0, x = v & 7, slot = (v >> 3) & 31, P = x * 2 + (slot >> 4); b = P >> 1; hh = P & 1; qb = slot & 15; row0 = b * SEQ + 128 * qb; }
            else if (u < e2) { const int v = u - e1; b = v >> 3; hh = (v >> 1) & 3; qb = v & 1; row0 = T_LAT + b * CTXL + 128 * qb; }
            else { const int v = u - e2; b = v >> 2; hh = (v >> 1) & 1; qb = v & 1; row0 = T_LAT + b * CTXL + 128 * qb; }
            if (!is_swa) {
                attn_unit<2, 128, false>(lds, QB + (size_t)row0 * 512 + hh * 128, 512, KB + (size_t)(b * 4 + hh) * NKEY * 128, VBt + (size_t)(b * 4 + hh) * NKEY * 128,
                                         is_ctx ? 4 : 36, 0, 0, 0, 0.f, lam, gsub, post_scale, O + (size_t)row0 * DM + 256 + hh * 128, tid);
            } else {
                const int kv = hh;
                int lo = 4 + 2 * (qb - 1), hi = 4 + 2 * (qb + 2); if (lo < 4) lo = 4; if (hi > 36) hi = 36;
                if (is_ctx) { lo = 0; hi = 0; }
                attn_unit<2, 64, true>(lds, QC + (size_t)row0 * 256 + kv * 128, 256, KC + (size_t)(b * 2 + kv) * NKEY * 64, VCt + (size_t)(b * 2 + kv) * NKEY * 64,
                                       4, lo, hi, 128 * qb, a.in[I_SINK][l * 4 + kv * 2] * LOG2E, a.in[I_SINK][l * 4 + kv * 2 + 1] * LOG2E, nullptr, 0.f, O + (size_t)row0 * DM + 768 + kv * 128, tid);
            }
        } else {
            const int v = u - e3, ch = v >> 2, h = v & 3;
            gmlp_unit(lds, UV, (const bf16_t*)(ws + WS_WS) + (size_t)(l * 4 + h) * 128 * 128, a.in[I_VGAIN] + (l * 4 + h) * 64, a.in[I_BS] + (l * 4 + h) * 128, ch * 128, h, O, tid);
        }
    }
}

__global__ void __launch_bounds__(512, 2) mega_fwd(Args a) {
    extern __shared__ __attribute__((aligned(16))) unsigned char lds_raw[];
    LAS unsigned char* lds = (LAS unsigned char*)lds_raw;
    cg::grid_group grid = cg::this_grid();
    const int G = gridDim.x;
    volatile LAS unsigned* MISC = (volatile LAS unsigned*)(lds + 131072);
    if (threadIdx.x < 64) MISC[threadIdx.x] = 0u;
    __syncthreads();
    const XcdBarrier xbar = xcd_barrier_post((unsigned*)a.ws, MISC + 8);
    for (int p = a.ph_lo; p < a.ph_hi; ++p) {
        int tid = threadIdx.x; asm volatile("" : "+v"(tid));
        unsigned char* ws = a.ws; asm volatile("" : "+s"(ws));
        if (p == 0) prologue_a(a, lds, tid, G);
        else if (p == 1) norm_phase(a, -1, 0, 0, 0, TT, 0.f, tid, G);
        else {
            const int q = p - 2, l = q / 10, st = q % 10; const bool last = (l == DEPTH - 1);
            const int Mfull = TT, Mlate = last ? T_LAT : TT;
            if (st == 0 || st == 7) {
                const int sub = (st == 7), M = sub ? Mlate : Mfull;
                pg8::Gemm g{(const bf16_t*)(ws + WS_Y), (const bf16_t*)(ws + WS_WGU) + (size_t)(l * 2 + sub) * NGU * DM, M, NGU, DM};
                pg8::StaticOrder S; S.init(M, NGU, G, (int)blockIdx.x); S.nkt = DM / pg8::BK;
                pg8::EpiSwiGLU E{(bf16_t*)(ws + WS_R1)};
                pg8::gemm_phase<pg8::EpiSwiGLU, pg8::StaticOrder, true, true>(lds, g, S, E, tid);
            } else if (st == 1 || st == 8 || st == 5) {
                pg8::Gemm g; int M;
                if (st == 5) { M = Mlate; g = pg8::Gemm{(const bf16_t*)(ws + R1_O), (const bf16_t*)(ws + WS_WOUT) + (size_t)l * DM * DM, M, DM, DM}; }
                else { const int sub = (st == 8); M = sub ? Mlate : Mfull; g = pg8::Gemm{(const bf16_t*)(ws + WS_R1), (const bf16_t*)(ws + WS_WD) + (size_t)(l * 2 + sub) * DM * DFF, M, DM, DFF}; }
                pg8::SplitOrder S; S.init(M, g.K, G, (int)blockIdx.x);
                pg8::EpiZ16 E{(bf16_t*)(ws + WS_Z)};
                pg8::gemm_phase<pg8::EpiZ16, pg8::SplitOrder, true, true>(lds, g, S, E, tid);
            } else if (st == 3) {
                pg8::Gemm g{(const bf16_t*)(ws + WS_Y), (const bf16_t*)(ws + WS_WIN) + (size_t)l * INC * DM, Mfull, INC, DM};
                pg8::StaticOrder S; S.init(Mfull, INC, G, (int)blockIdx.x); S.nkt = DM / pg8::BK;
                pg8::EpiInProj E{(bf16_t*)(ws + R1_UV), (bf16_t*)(ws + R1_QB), (bf16_t*)(ws + R1_QC), (bf16_t*)(ws + R1_KB), (bf16_t*)(ws + R1_VB), (bf16_t*)(ws + R1_KC), (bf16_t*)(ws + R1_VC), (const f32x2*)(ws + WS_ROPE)};
                pg8::gemm_phase<pg8::EpiInProj, pg8::StaticOrder, true, true>(lds, g, S, E, tid);
            } else if (st == 4) {
                mix_phase(a, lds, l, tid, G);
            } else {
                const int j = (st == 2) ? 0 : (st == 6 ? 1 : 2);
                const int l2 = (j == 2) ? l + 1 : l, j2 = (j == 2) ? 0 : j + 1;
                const int nrows = (j == 0) ? Mfull : Mlate;
                norm_phase(a, l, j, l2, j2, nrows, (j == 1) ? 1.0f : 0.5f, tid, G);
            }
        }
        if (p + 1 < a.ph_hi) { if (a.ph_hi > NPHASE) grid.sync(); else xcd_barrier(xbar); }
    }
}

extern "C" void kernel_launch(void* const* d_in, const int* in_sizes, int n_in, void* d_out, int out_size, void* d_ws, size_t ws_size, hipStream_t stream) {
    static int grid = 0;
    if (grid == 0) {
        if (n_in != 19 || out_size != T_LAT * DM || ws_size < WS_NEED) { fprintf(stderr, "kernel_launch: unexpected shapes (n_in %d out %d ws %zu)\n", n_in, out_size, ws_size); grid = -1; return; }
        int dev = 0, cus = 0, per_cu = 0;
        (void)hipGetDevice(&dev);
        (void)hipDeviceGetAttribute(&cus, hipDeviceAttributeMultiprocessorCount, dev);
        if (hipFuncSetAttribute((const void*)mega_fwd, hipFuncAttributeMaxDynamicSharedMemorySize, LDS_BYTES) != hipSuccess) { fprintf(stderr, "kernel_launch: hipFuncSetAttribute failed\n"); grid = -1; return; }
        if (hipOccupancyMaxActiveBlocksPerMultiprocessor(&per_cu, (const void*)mega_fwd, 512, LDS_BYTES) != hipSuccess || per_cu < 1) { fprintf(stderr, "kernel_launch: occupancy query gave %d\n", per_cu); per_cu = 1; }
        (void)hipGetLastError();
        grid = cus * 1;
        if (grid <= 0) grid = 256;
    }
    if (grid < 0) return;
    (void)hipMemsetAsync(d_ws, 0, 65536, stream);
    Args a{};
    for (int i = 0; i < 19; ++i) a.in[i] = (const float*)d_in[i];
    a.out = (float*)d_out; a.ws = (unsigned char*)d_ws; a.ph_lo = 0; a.ph_hi = NPHASE;
    void* args[] = {&a};
    hipError_t e = hipLaunchCooperativeKernel((const void*)mega_fwd, dim3(grid), dim3(512), args, LDS_BYTES, stream);
    if (e != hipSuccess) fprintf(stderr, "kernel_launch: cooperative launch failed: %s (grid %d)\n", hipGetErrorString(e), grid);
}
```

```cpp
#include <hip/hip_runtime.h>
#include <hip/hip_cooperative_groups.h>
#include <cstdio>
#include <cstdint>
namespace cg = cooperative_groups;

#define LAS __attribute__((address_space(3)))
typedef unsigned short bf16_t;
typedef short bf16x8 __attribute__((ext_vector_type(8)));
typedef short s16x4 __attribute__((ext_vector_type(4)));
typedef float f32x4 __attribute__((ext_vector_type(4)));
typedef float f32x2 __attribute__((ext_vector_type(2)));
typedef unsigned u32x4 __attribute__((ext_vector_type(4)));
typedef unsigned u32x2 __attribute__((ext_vector_type(2)));

constexpr int DM = 1024, NB = 8, SEQ = 2048, CTXL = 256, DEPTH = 4, DFF = 2816, NGU = 2 * DFF, INC = 2560, NKEY = SEQ + CTXL;
constexpr int T_LAT = NB * SEQ, T_CTX = NB * CTXL, TT = T_LAT + T_CTX;
constexpr float EPSV = 1e-6f;
constexpr float QSCALE = 0.125f * 1.4426950408889634f;
constexpr float LOG2E = 1.4426950408889634f;

constexpr size_t MiB = 1u << 20;
constexpr size_t WS_MOD = 1 * MiB;
constexpr size_t WS_ROPE = 3 * MiB;
constexpr size_t WS_LAM = 3 * MiB + 65536;
constexpr size_t WS_WS = 4 * MiB;
constexpr size_t WS_WGU = 8 * MiB;
constexpr size_t WS_WD = 96 * MiB;
constexpr size_t WS_WIN = 140 * MiB;
constexpr size_t WS_WOUT = 160 * MiB;
constexpr size_t WS_H = 168 * MiB;
constexpr size_t WS_S16 = 276 * MiB;
constexpr size_t WS_Y = 176 * MiB;
constexpr size_t WS_Z = 212 * MiB;
constexpr size_t WS_R1 = 340 * MiB;
constexpr size_t R1_UV = WS_R1;
constexpr size_t R1_QB = R1_UV + (size_t)TT * 512 * 2;
constexpr size_t R1_QC = R1_QB + (size_t)TT * 512 * 2;
constexpr size_t R1_KB = R1_QC + (size_t)TT * 256 * 2;
constexpr size_t R1_VB = R1_KB + (size_t)NB * 4 * NKEY * 128 * 2;
constexpr size_t R1_KC = R1_VB + (size_t)NB * 4 * NKEY * 128 * 2;
constexpr size_t R1_VC = R1_KC + (size_t)NB * 2 * NKEY * 64 * 2;
constexpr size_t R1_O = R1_VC + (size_t)NB * 2 * NKEY * 64 * 2;
constexpr size_t WS_END = R1_O + (size_t)TT * 1024 * 2;
static_assert(WS_Z + (size_t)(T_LAT + 8 * T_CTX) * DM * 4 <= WS_R1 && WS_R1 + (size_t)TT * DFF * 2 <= 476 * MiB && WS_END <= 476 * MiB, "ws map");
constexpr size_t WS_NEED = 476 * MiB;

constexpr int LDS_BYTES = 131072 + 2048;
constexpr int NPHASE = 2 + 10 * DEPTH;

__device__ __forceinline__ unsigned cvt_pk_bf16(float lo, float hi) { unsigned r; asm volatile("v_cvt_pk_bf16_f32 %0, %1, %2" : "=v"(r) : "v"(lo), "v"(hi)); return r; }
__device__ __forceinline__ float wave_sum(float v) {
#pragma unroll
    for (int o = 1; o < 64; o <<= 1) v += __shfl_xor(v, o);
    return v;
}
__device__ __forceinline__ float fmax2(float a, float b) { return __builtin_amdgcn_fmed3f(a, b, 3.0e38f); }
__device__ __forceinline__ float silu_f(float g) { return g * __builtin_amdgcn_rcpf(1.f + __expf(-g)); }
__device__ __forceinline__ float gelu_tanh_f(float x) { const float y = 1.5957691216057308f * (x + 0.044715f * x * x * x); return x * __builtin_amdgcn_rcpf(1.f + __expf(-y)); }

namespace pg8 {
constexpr int BM = 256, BK = 64, HALF = 128, HTB = HALF * BK * 2, STAGE_BYTES = 8 * HTB, NXCD = 8, WGM = 8;
__host__ __device__ __forceinline__ int lds_byte(int r, int c) { const int st = (r >> 4) * 2 + (c >> 5), rr = r & 15, cc = c & 31, ob = rr * 64 + cc * 2; return st * 1024 + (ob ^ (((ob >> 9) & 1) << 5)); }
__host__ __device__ __forceinline__ void stage_rc(int b, int& R, int& C) { const int st = b / 1024, sb = b % 1024, swz = sb ^ (((sb >> 9) & 1) << 5); R = (st >> 1) * 16 + swz / 64; C = (st & 1) * 32 + (swz % 64) / 2; }
__host__ __device__ __forceinline__ int perm32(int rho) { const int n = rho >> 4, i = rho & 15; return 8 * (i >> 2) + 4 * n + (i & 3); }

struct Unit { int pm, pn, k0, nk, part; };
struct Gemm { const bf16_t* A; const bf16_t* Bt; int M, N, K; };

struct StaticOrder {
    int nM, nN, nwg, G, c, nkt;
    __host__ __device__ void init(int M, int N, int G_, int c_) { nM = M / BM; nN = N / BM; nwg = nM * nN; G = G_; c = c_; nkt = 0; }
    __host__ __device__ bool next(int i, Unit& u) const {
        const long L = (long)i * G + c; if (L >= nwg) return false;
        int wgid = (int)L; { const int q = nwg / NXCD, r = nwg % NXCD, xcd = wgid % NXCD, off = wgid / NXCD; wgid = (xcd < r ? xcd * (q + 1) : r * (q + 1) + (xcd - r) * q) + off; }
        const int nig = WGM * nN, gid = wgid / nig, fm = gid * WGM, gsz = (nM - fm) < WGM ? (nM - fm) : WGM;
        u.pm = fm + ((wgid % nig) % gsz); u.pn = (wgid % nig) / gsz; u.k0 = 0; u.nk = nkt; u.part = -1; return true;
    }
    __device__ __forceinline__ void a_ready(const Unit&) const {}
    __device__ __forceinline__ void done(const Unit&) const {}
};
struct SplitOrder {
    int G, c, nitems, nkt;
    __host__ __device__ void init(int M, int K, int G_, int c_) { G = G_; c = c_; nkt = K / BK; nitems = 256 + (M > T_LAT ? 256 : 0); }
    __host__ __device__ bool next(int i, Unit& u) const {
        const int L = i * G + c; if (L >= nitems) return false;
        const int w = (L & 7) * 32 + ((L >> 3) & 31), lpm = (w >> 5) * 8 + (w & 7), lpn = (w & 31) >> 3;
        const int v = L - 256, cu = v >> 3, part = v & 7;
        const bool ctx = L >= 256;
        const int ck0 = (nkt == 44) ? (part < 6 ? 6 * part : 36 + 4 * (part - 6)) : part * (nkt >> 3);
        const int cnk = (nkt == 44) ? (part < 6 ? 6 : 4) : (nkt >> 3);
        u.pm = ctx ? 64 + (cu >> 2) : lpm; u.pn = ctx ? (cu & 3) : lpn; u.part = ctx ? part : -1; u.k0 = ctx ? ck0 : 0; u.nk = ctx ? cnk : nkt;
        return true;
    }
    __device__ __forceinline__ void a_ready(const Unit&) const {}
    __device__ __forceinline__ void done(const Unit&) const {}
};


struct EpiSwiGLU {
    static constexpr bool PERM = true, AFTER_DRAIN = false;
    bf16_t* O;
    __device__ __forceinline__ void operator()(const f32x4 (&acc)[2][2][4][2], const Unit& u, int wr, int wc, int fr, int fq) const {
        const int row0 = u.pm * BM + wr * 64 + fr, col0 = u.pn * 128 + wc * 32 + 8 * fq;
#pragma unroll
        for (int ai = 0; ai < 2; ++ai)
#pragma unroll
            for (int m = 0; m < 4; ++m) {
                bf16_t* p = O + (size_t)(row0 + ai * HALF + m * 16) * DFF + col0;
                const f32x4 g0 = acc[ai][0][m][0], g1 = acc[ai][0][m][1], u0 = acc[ai][1][m][0], u1 = acc[ai][1][m][1];
                u32x4 w;
#define SGLU(g_, u_) ((g_) * (u_) * __builtin_amdgcn_rcpf(1.f + __builtin_amdgcn_exp2f(-(g_))))
                w.x = cvt_pk_bf16(SGLU(g0[0], u0[0]), SGLU(g0[1], u0[1])); w.y = cvt_pk_bf16(SGLU(g0[2], u0[2]), SGLU(g0[3], u0[3]));
                w.z = cvt_pk_bf16(SGLU(g1[0], u1[0]), SGLU(g1[1], u1[1])); w.w = cvt_pk_bf16(SGLU(g1[2], u1[2]), SGLU(g1[3], u1[3]));
#undef SGLU
                *(u32x4*)p = w;
            }
    }
};
struct EpiZ16 {
    static constexpr bool PERM = true, AFTER_DRAIN = false;
    bf16_t* Z;
    __device__ __forceinline__ void operator()(const f32x4 (&acc)[2][2][4][2], const Unit& u, int wr, int wc, int fr, int fq) const {
        const int row0 = u.pm * BM + wr * 64 + fr + (u.part > 0 ? u.part * T_CTX : 0), col0 = u.pn * BM + wc * 32 + 8 * fq;
#pragma unroll
        for (int ai = 0; ai < 2; ++ai)
#pragma unroll
            for (int m = 0; m < 4; ++m) {
                bf16_t* p = Z + (size_t)(row0 + ai * HALF + m * 16) * DM + col0;
#pragma unroll
                for (int bj = 0; bj < 2; ++bj) { const f32x4 v0 = acc[ai][bj][m][0], v1 = acc[ai][bj][m][1];
                    *(u32x4*)(p + bj * HALF) = (u32x4){cvt_pk_bf16(v0[0], v0[1]), cvt_pk_bf16(v0[2], v0[3]), cvt_pk_bf16(v1[0], v1[1]), cvt_pk_bf16(v1[2], v1[3])}; }
            }
    }
};
struct EpiInProj {
    static constexpr bool PERM = false, AFTER_DRAIN = false;
    bf16_t *UV, *QB, *QC, *KB, *VBt, *KC, *VCt; const f32x2* rope;
    __device__ __forceinline__ void operator()(const f32x4 (&acc)[2][2][4][2], const Unit& u, int wr, int wc, int fr, int fq) const {
        const int pn = u.pn; const bool lat = u.pm < (T_LAT / BM);
#pragma unroll
        for (int ai = 0; ai < 2; ++ai)
#pragma unroll
            for (int m = 0; m < 4; ++m) {
                const int r = u.pm * BM + ai * HALF + wr * 64 + m * 16 + fr;
                int b, s, keyidx;
                if (lat) { b = r >> 11; s = r & 2047; keyidx = CTXL + s; } else { const int rc = r - T_LAT; b = rc >> 8; s = 0; keyidx = rc & 255; }
#pragma unroll
                for (int bj = 0; bj < 2; ++bj) {
                    f32x4 v0 = acc[ai][bj][m][0], v1 = acc[ai][bj][m][1];
                    const bool is_rope = (pn >= 2 && pn <= 6) || (pn == 9 && bj == 0);
                    if (is_rope && lat) {
                        const int pos = (wc & 1) ? (s & 63) : (s >> 6);
                        const f32x4 c01 = *(const f32x4*)(rope + pos * 16 + 4 * fq), c23 = *(const f32x4*)(rope + pos * 16 + 4 * fq + 2);
                        const float cs[4] = {c01[0], c01[2], c23[0], c23[2]}, sn[4] = {c01[1], c01[3], c23[1], c23[3]};
#pragma unroll
                        for (int i = 0; i < 4; ++i) { const float x0 = v0[i], x1 = v1[i]; v0[i] = x0 * cs[i] - x1 * sn[i]; v1[i] = x1 * cs[i] + x0 * sn[i]; }
                    }
                    const int ctb = bj * HALF + wc * 32 + 4 * fq;
                    if (pn <= 1) {
#pragma unroll
                        for (int i = 0; i < 4; ++i) { v0[i] = gelu_tanh_f(v0[i]); v1[i] = gelu_tanh_f(v1[i]); }
                        bf16_t* p = UV + (size_t)r * 512 + pn * 256 + ctb;
                        *(u32x2*)p = (u32x2){cvt_pk_bf16(v0[0], v0[1]), cvt_pk_bf16(v0[2], v0[3])}; *(u32x2*)(p + 16) = (u32x2){cvt_pk_bf16(v1[0], v1[1]), cvt_pk_bf16(v1[2], v1[3])};
                    } else if (pn <= 4) {
                        v0 = v0 * QSCALE; v1 = v1 * QSCALE;
                        bf16_t* p = (pn <= 3) ? QB + (size_t)r * 512 + (pn - 2) * 256 + ctb : QC + (size_t)r * 256 + ctb;
                        *(u32x2*)p = (u32x2){cvt_pk_bf16(v0[0], v0[1]), cvt_pk_bf16(v0[2], v0[3])}; *(u32x2*)(p + 16) = (u32x2){cvt_pk_bf16(v1[0], v1[1]), cvt_pk_bf16(v1[2], v1[3])};
                    } else if (pn <= 6) {
                        const int ck = (pn - 5) * 256 + ctb, head = ck >> 7, cw = ck & 127;
                        bf16_t* p = KB + ((size_t)(b * 4 + head) * NKEY + keyidx) * 128 + cw;
                        *(u32x2*)p = (u32x2){cvt_pk_bf16(v0[0], v0[1]), cvt_pk_bf16(v0[2], v0[3])}; *(u32x2*)(p + 16) = (u32x2){cvt_pk_bf16(v1[0], v1[1]), cvt_pk_bf16(v1[2], v1[3])};
                    } else if (pn <= 8) {
                        const int cv = (pn - 7) * 256 + ctb, head = cv >> 7, e = cv & 127;
                        bf16_t* p = VBt + ((size_t)(b * 4 + head) * NKEY + keyidx) * 128 + e;
                        *(u32x2*)p = (u32x2){cvt_pk_bf16(v0[0], v0[1]), cvt_pk_bf16(v0[2], v0[3])}; *(u32x2*)(p + 16) = (u32x2){cvt_pk_bf16(v1[0], v1[1]), cvt_pk_bf16(v1[2], v1[3])};
                    } else {
                        const int kv = wc >> 1, d = (wc & 1) * 32 + 4 * fq;
                        if (bj == 0) {
                            bf16_t* p = KC + ((size_t)(b * 2 + kv) * NKEY + keyidx) * 64 + d;
                            *(u32x2*)p = (u32x2){cvt_pk_bf16(v0[0], v0[1]), cvt_pk_bf16(v0[2], v0[3])}; *(u32x2*)(p + 16) = (u32x2){cvt_pk_bf16(v1[0], v1[1]), cvt_pk_bf16(v1[2], v1[3])};
                        } else {
                            bf16_t* p = VCt + ((size_t)(b * 2 + kv) * NKEY + keyidx) * 64 + d;
                            *(u32x2*)p = (u32x2){cvt_pk_bf16(v0[0], v0[1]), cvt_pk_bf16(v0[2], v0[3])}; *(u32x2*)(p + 16) = (u32x2){cvt_pk_bf16(v1[0], v1[1]), cvt_pk_bf16(v1[2], v1[3])};
                        }
                    }
                }
                asm volatile("" ::: "memory");
            }
    }
};

template <class Epi, class Sched, bool ALIGN_EPI = false, bool SP2 = false>
__device__ __forceinline__ void gemm_phase(LAS unsigned char* lds, const Gemm g, const Sched& S, const Epi& E, const int tid) {
    const int wid = __builtin_amdgcn_readfirstlane(tid >> 6), lane = tid & 63, wr = wid >> 2, wc = wid & 3, fr = lane & 15, fq = lane >> 4;
    const int K = g.K;
    unsigned voffA[2], voffB[2];
#pragma unroll
    for (int i = 0; i < 2; ++i) { int R, C; stage_rc(tid * 16 + i * 8192, R, C); const int Rb = Epi::PERM ? ((R & ~31) + perm32(R & 31)) : R;
        voffA[i] = (unsigned)(R * K + C) * 2u; voffB[i] = (unsigned)(Rb * K + C) * 2u; }
    const size_t kstep = (size_t)(BK * 2);
    const size_t hstep = (size_t)HALF * K * 2;
    const size_t tstep = 2 * hstep;
    const unsigned ldsw = (unsigned)wid * 1024u;
    const int aoff = lds_byte(wr * 64 + fr, fq * 8), boff = lds_byte(wc * 32 + fr, fq * 8);
#define PG8_SA(b, h) (((b) * 2 + (h)) * HTB)
#define PG8_SB(b, h) ((4 + (b) * 2 + (h)) * HTB)
#define PG8_STAGE(bufoff, gbase, voff) do { _Pragma("unroll") for (int _i = 0; _i < 2; ++_i) \
        __builtin_amdgcn_global_load_lds((const unsigned*)((const char*)(gbase) + (voff)[_i]), (LAS unsigned*)(lds + (bufoff) + ldsw + _i * 8192), 16, 0, 0); } while (0)
#define PG8_LDA(dst, b, h) do { _Pragma("unroll") for (int m = 0; m < 4; ++m) _Pragma("unroll") for (int k = 0; k < 2; ++k) dst[m][k] = *(const LAS bf16x8*)(lds + PG8_SA(b, h) + aoff + m * 2048 + k * 1024); } while (0)
#define PG8_LDB(dst, b, h) do { _Pragma("unroll") for (int n = 0; n < 2; ++n) _Pragma("unroll") for (int k = 0; k < 2; ++k) dst[n][k] = *(const LAS bf16x8*)(lds + PG8_SB(b, h) + boff + n * 2048 + k * 1024); } while (0)
#define PG8_MMA(ai, bj, At, Bt) do { __builtin_amdgcn_s_setprio(1); _Pragma("unroll") for (int m = 0; m < 4; ++m) _Pragma("unroll") for (int n = 0; n < 2; ++n) _Pragma("unroll") for (int k = 0; k < 2; ++k) \
        acc[ai][bj][m][n] = __builtin_amdgcn_mfma_f32_16x16x32_bf16(Bt[n][k], At[m][k], acc[ai][bj][m][n], 0, 0, 0); __builtin_amdgcn_s_setprio(0); } while (0)
#define PG8_WAIT_V(n) asm volatile("s_waitcnt vmcnt(" #n ")" ::: "memory")
#define PG8_WAIT_L(n) asm volatile("s_waitcnt lgkmcnt(" #n ")" ::: "memory")
#define PG8_BAR __builtin_amdgcn_s_barrier()
#define PG8_SCHED __builtin_amdgcn_sched_barrier(0)
    Unit cur, nxt; int ui = 0;
    if (!S.next(0, cur)) return;
    f32x4 acc[2][2][4][2];
#pragma unroll
    for (int a = 0; a < 2; ++a)
#pragma unroll
        for (int b = 0; b < 2; ++b)
#pragma unroll
            for (int m = 0; m < 4; ++m)
#pragma unroll
                for (int n = 0; n < 2; ++n) acc[a][b][m][n] = (f32x4){0.f, 0.f, 0.f, 0.f};
    bf16x8 At[4][2], B0[2][2], B1[2][2];
    const char* cA = (const char*)g.A + (size_t)cur.pm * tstep + (size_t)cur.k0 * kstep; const char* cB = (const char*)g.Bt + (size_t)cur.pn * tstep + (size_t)cur.k0 * kstep;
    S.a_ready(cur);
    if constexpr (SP2) {
        PG8_STAGE(PG8_SB(0, 0), cB, voffB); PG8_STAGE(PG8_SB(0, 1), cB + hstep, voffB); PG8_STAGE(PG8_SA(0, 0), cA, voffA); PG8_STAGE(PG8_SA(0, 1), cA + hstep, voffA);
        if (wr == 1) PG8_BAR;
        PG8_WAIT_V(2); PG8_BAR;
        PG8_STAGE(PG8_SB(1, 0), cB + kstep, voffB); PG8_STAGE(PG8_SA(1, 0), cA + kstep, voffA); PG8_STAGE(PG8_SB(1, 1), cB + hstep + kstep, voffB);
        PG8_WAIT_V(6); PG8_BAR;
    } else {
        PG8_STAGE(PG8_SB(0, 0), cB, voffB); PG8_STAGE(PG8_SA(0, 0), cA, voffA); PG8_STAGE(PG8_SB(0, 1), cB + hstep, voffB); PG8_STAGE(PG8_SA(0, 1), cA + hstep, voffA);
        if (wr == 1) PG8_BAR;
        PG8_WAIT_V(4); PG8_BAR;
        PG8_STAGE(PG8_SB(1, 0), cB + kstep, voffB); PG8_STAGE(PG8_SA(1, 0), cA + kstep, voffA); PG8_STAGE(PG8_SB(1, 1), cB + hstep + kstep, voffB);
        PG8_WAIT_V(6); PG8_BAR;
    }
    for (;;) {
        const bool has_next = S.next(ui + 1, nxt);
        const char* nA = has_next ? (const char*)g.A + (size_t)nxt.pm * tstep + (size_t)nxt.k0 * kstep : cA; const char* nB = has_next ? (const char*)g.Bt + (size_t)nxt.pn * tstep + (size_t)nxt.k0 * kstep : cB;
        const int nt = cur.nk;
        for (int t = 0; t < nt; t += 2) {
            const bool last = (t == nt - 2);
            const char* a1 = cA + (size_t)(t + 1) * kstep;
            const char* a2 = last ? nA : cA + (size_t)(t + 2) * kstep; const char* b2 = last ? nB : cB + (size_t)(t + 2) * kstep;
            const char* a3 = a2 + kstep; const char* b3 = b2 + kstep;
            if (last && has_next) S.a_ready(nxt);
            if constexpr (SP2) {
            PG8_LDB(B0, 0, 0); PG8_LDB(B1, 0, 1); PG8_SCHED; PG8_LDA(At, 0, 0); PG8_STAGE(PG8_SA(1, 1), a1 + hstep, voffA);
            PG8_WAIT_V(8); PG8_WAIT_L(0); PG8_BAR; PG8_MMA(0, 0, At, B0); PG8_MMA(0, 1, At, B1); PG8_BAR; PG8_SCHED;
            PG8_LDA(At, 0, 1); PG8_STAGE(PG8_SB(0, 0), b2, voffB); PG8_STAGE(PG8_SB(0, 1), b2 + hstep, voffB); PG8_STAGE(PG8_SA(0, 0), a2, voffA);
            PG8_WAIT_V(8); PG8_WAIT_L(0); PG8_BAR; PG8_MMA(1, 0, At, B0); PG8_MMA(1, 1, At, B1); PG8_BAR; PG8_SCHED;
            PG8_LDB(B0, 1, 0); PG8_LDB(B1, 1, 1); PG8_SCHED; PG8_LDA(At, 1, 0); PG8_STAGE(PG8_SA(0, 1), a2 + hstep, voffA);
            PG8_WAIT_V(8); PG8_WAIT_L(0); PG8_BAR; PG8_MMA(0, 0, At, B0); PG8_MMA(0, 1, At, B1); PG8_BAR; PG8_SCHED;
            PG8_LDA(At, 1, 1); PG8_STAGE(PG8_SB(1, 0), b3, voffB); PG8_STAGE(PG8_SB(1, 1), b3 + hstep, voffB); PG8_STAGE(PG8_SA(1, 0), a3, voffA);
            PG8_WAIT_V(8); PG8_WAIT_L(0); PG8_BAR; PG8_MMA(1, 0, At, B0); PG8_MMA(1, 1, At, B1); PG8_BAR; PG8_SCHED;
            } else {
            PG8_LDB(B0, 0, 0); PG8_SCHED; PG8_LDA(At, 0, 0); PG8_STAGE(PG8_SA(1, 1), a1 + hstep, voffA);
            PG8_WAIT_L(8); PG8_BAR; PG8_WAIT_L(0); PG8_MMA(0, 0, At, B0); PG8_BAR; PG8_SCHED;
            PG8_LDB(B1, 0, 1); PG8_STAGE(PG8_SB(0, 0), b2, voffB);
            PG8_BAR; PG8_WAIT_L(0); PG8_MMA(0, 1, At, B1); PG8_BAR;
            PG8_LDA(At, 0, 1); PG8_STAGE(PG8_SA(0, 0), a2, voffA);
            PG8_BAR; PG8_WAIT_L(0); PG8_MMA(1, 0, At, B0); PG8_BAR; PG8_SCHED;
            PG8_STAGE(PG8_SB(0, 1), b2 + hstep, voffB);
            PG8_WAIT_V(6); PG8_BAR; PG8_MMA(1, 1, At, B1); PG8_BAR;
            PG8_LDB(B0, 1, 0); PG8_SCHED; PG8_LDA(At, 1, 0); PG8_STAGE(PG8_SA(0, 1), a2 + hstep, voffA);
            PG8_WAIT_L(8); PG8_BAR; PG8_WAIT_L(0); PG8_MMA(0, 0, At, B0); PG8_BAR; PG8_SCHED;
            PG8_LDB(B1, 1, 1); PG8_STAGE(PG8_SB(1, 0), b3, voffB);
            PG8_BAR; PG8_WAIT_L(0); PG8_MMA(0, 1, At, B1); PG8_BAR;
            PG8_LDA(At, 1, 1); PG8_STAGE(PG8_SA(1, 0), a3, voffA);
            PG8_BAR; PG8_WAIT_L(0); PG8_MMA(1, 0, At, B0); PG8_BAR; PG8_SCHED;
            PG8_STAGE(PG8_SB(1, 1), b3 + hstep, voffB);
            PG8_WAIT_V(6); PG8_BAR; PG8_MMA(1, 1, At, B1); PG8_BAR;
            }
        }
        if constexpr (ALIGN_EPI) { if (wr == 0) PG8_BAR; }
        if constexpr (!Epi::AFTER_DRAIN) { E(acc, cur, wr, wc, fr, fq); S.done(cur); }
        if (!has_next) break;
#pragma unroll
        for (int a = 0; a < 2; ++a)
#pragma unroll
            for (int b = 0; b < 2; ++b)
#pragma unroll
                for (int m = 0; m < 4; ++m)
#pragma unroll
                    for (int n = 0; n < 2; ++n) acc[a][b][m][n] = (f32x4){0.f, 0.f, 0.f, 0.f};
        cur = nxt; cA = nA; cB = nB; ++ui;
        if constexpr (ALIGN_EPI) { if (wr == 1) PG8_BAR; }
    }
    PG8_WAIT_V(0);
    if constexpr (!ALIGN_EPI) { if (wr == 0) PG8_BAR; }
    PG8_BAR;
#undef PG8_SA
#undef PG8_SB
#undef PG8_STAGE
#undef PG8_LDA
#undef PG8_LDB
#undef PG8_MMA
#undef PG8_WAIT_V
#undef PG8_WAIT_L
#undef PG8_BAR
#undef PG8_SCHED
}
}


#define XB_TMO      128
#define XB_XCNT(j)  (256  + 64 * (j))
#define XB_XSUB(j)  (1280 + 64 * (j))
#define XB_XGEN(j)  (2304 + 64 * (j))
#define XB_TOP      3328
#define XB_TOPGEN   3392
#define XCD_BAR_WORDS 3456
#define XB_SPIN_CAP (1u << 18)
__device__ __forceinline__ unsigned xb_ld(unsigned* p)              { return __hip_atomic_load(p, __ATOMIC_RELAXED, __HIP_MEMORY_SCOPE_AGENT); }
__device__ __forceinline__ unsigned xb_add(unsigned* p, unsigned v) { return __hip_atomic_fetch_add(p, v, __ATOMIC_RELAXED, __HIP_MEMORY_SCOPE_AGENT); }
__device__ __forceinline__ unsigned xb_xcc_id() { return (unsigned)__builtin_amdgcn_s_getreg((3 << 11) | 20) & 0xFu; }
#define XB_SPIN(cond, bar) do { unsigned _sp = 0; while (cond) { __builtin_amdgcn_s_sleep(1); \
    if ((++_sp & 255u) == 0u) { if (xb_ld(&(bar)[XB_TMO])) break; if (_sp > XB_SPIN_CAP) { atomicAdd(&(bar)[XB_TMO], 1u); break; } } } } while (0)
struct XcdBarrier { unsigned* bar; unsigned x; volatile LAS unsigned* st; };
__device__ __forceinline__ XcdBarrier xcd_barrier_post(unsigned* bar, volatile LAS unsigned* st) {
    XcdBarrier b; b.bar = bar; b.x = xb_xcc_id(); b.st = st;
    if (threadIdx.x == 0) (void)xb_add(&bar[XB_XCNT(b.x)], 1u);
    return b;
}
__device__ __forceinline__ void xcd_barrier_complete(unsigned* bar, unsigned x, unsigned& nloc, unsigned& nx) {
    const unsigned G = gridDim.x * gridDim.y * gridDim.z;
    unsigned sum, cnt, mine, sp = 0u;
    for (;;) {
        sum = 0u; cnt = 0u; mine = 0u;
#pragma unroll
        for (unsigned j = 0; j < 16; ++j) { const unsigned c = xb_ld(&bar[XB_XCNT(j)]); sum += c; cnt += (c > 0u) ? 1u : 0u; mine = (j == x) ? c : mine; }
        if (sum == G) break;
        __builtin_amdgcn_s_sleep(1);
        if ((++sp & 255u) == 0u) { if (xb_ld(&bar[XB_TMO])) break; if (sp > XB_SPIN_CAP) { atomicAdd(&bar[XB_TMO], 1u); break; } }
    }
    nloc = mine > 0u ? mine : 1u; nx = cnt > 0u ? cnt : 1u;
}
__device__ __forceinline__ void xcd_barrier(const XcdBarrier& b) {
    asm volatile("s_waitcnt vmcnt(0)" ::: "memory");
    __syncthreads();
    if (threadIdx.x == 0) {
        unsigned* bar = b.bar;
        __builtin_amdgcn_s_waitcnt(0);
        unsigned nloc = b.st[0], nx = b.st[1];
        if (nloc == 0u) { xcd_barrier_complete(bar, b.x, nloc, nx); b.st[0] = nloc; b.st[1] = nx; }
        const unsigned old = xb_add(&bar[XB_XSUB(b.x)], 1u);
        const unsigned gen = old / nloc;
        if (old + 1u == (gen + 1u) * nloc) {
            __builtin_amdgcn_fence(__ATOMIC_RELEASE, "agent");
            asm volatile("s_waitcnt vmcnt(0)" ::: "memory");
            const unsigned og = xb_add(&bar[XB_TOP], 1u);
            const unsigned tg = og / nx;
            if (og + 1u == (tg + 1u) * nx) xb_add(&bar[XB_TOPGEN], 1u);
            else XB_SPIN(xb_ld(&bar[XB_TOPGEN]) == tg, bar);
            __builtin_amdgcn_fence(__ATOMIC_ACQUIRE, "agent");
            xb_add(&bar[XB_XGEN(b.x)], 1u);
            asm volatile("s_waitcnt vmcnt(0)" ::: "memory");
        } else {
            XB_SPIN(xb_ld(&bar[XB_XGEN(b.x)]) == gen, bar);
            __builtin_amdgcn_fence(__ATOMIC_ACQUIRE, "agent");
            asm volatile("s_waitcnt vmcnt(0)" ::: "memory");
        }
    }
    __syncthreads();
}

struct Args { const float* in[19]; float* out; unsigned char* ws; int ph_lo, ph_hi; };
enum { I_X = 0, I_C, I_CTX, I_CCTX, I_WMOD, I_BMOD, I_NPRE, I_NPOST, I_WG, I_WU, I_WD, I_WIN, I_WOUT, I_VGAIN, I_WS, I_BS, I_LAM, I_SUBLN, I_SINK };

#define LDS_WAIT() asm volatile("s_waitcnt lgkmcnt(0)" ::: "memory")

__device__ __forceinline__ void transpose_item(const float* __restrict__ W, int N, int k0, int n0, bf16_t* __restrict__ WT, int K, int drow0, LAS float* scr, int lane, float wscale = 1.0f) {
#pragma unroll 8
    for (int i = 0; i < 32; ++i) { const int kk = 2 * i + (lane >> 5); scr[kk * 33 + (lane & 31)] = __builtin_nontemporal_load(W + (size_t)(k0 + kk) * N + n0 + (lane & 31)); }
    LDS_WAIT(); asm volatile("" ::: "memory");
    const int c = lane & 7;
#pragma unroll
    for (int j = 0; j < 4; ++j) { const int n = (lane >> 3) + 8 * j; const LAS float* s = scr + (8 * c) * 33 + n;
        u32x4 o; o.x = cvt_pk_bf16(s[0 * 33] * wscale, s[1 * 33] * wscale); o.y = cvt_pk_bf16(s[2 * 33] * wscale, s[3 * 33] * wscale); o.z = cvt_pk_bf16(s[4 * 33] * wscale, s[5 * 33] * wscale); o.w = cvt_pk_bf16(s[6 * 33] * wscale, s[7 * 33] * wscale);
        __builtin_nontemporal_store(o, (u32x4*)(WT + (size_t)(drow0 + n0 + n) * K + k0 + 8 * c)); }
    LDS_WAIT(); asm volatile("" ::: "memory");
}

__device__ __forceinline__ void prologue_a(const Args& a, LAS unsigned char* lds, int tid, int G) {
    const int lane = tid & 63, wave = tid >> 6;
    unsigned char* ws = a.ws;
    {
        LAS float* scr = (LAS float*)(lds + wave * 16384);
        const int gw = blockIdx.x * 8 + wave, NGW = G * 8;
        constexpr int PER_L = 10240;
        for (int it = gw; it < DEPTH * PER_L; it += NGW) {
            const int l = it / PER_L; int r = it % PER_L;
            if (r < 5632) {
                const int up = r >= 2816; if (up) r -= 2816;
                const int sub = r / 1408, rr = r % 1408, kb = rr / 88, nb = rr % 88, n0 = nb * 32;
                const float* W = a.in[up ? I_WU : I_WG] + (size_t)(l * 2 + sub) * DM * DFF;
                bf16_t* WT = (bf16_t*)(ws + WS_WGU) + (size_t)(l * 2 + sub) * NGU * DM;
                transpose_item(W, DFF, kb * 64, n0, WT, DM, 256 * (n0 >> 7) + (up ? 128 : 0) + (n0 & 127) - n0, scr, lane, up ? (1.0f / LOG2E) : LOG2E);
            } else if (r < 8448) {
                r -= 5632; const int sub = r / 1408, rr = r % 1408, kb = rr / 32, nb = rr % 32;
                const float* W = a.in[I_WD] + (size_t)(l * 2 + sub) * DFF * DM;
                bf16_t* WT = (bf16_t*)(ws + WS_WD) + (size_t)(l * 2 + sub) * DM * DFF;
                transpose_item(W, DM, kb * 64, nb * 32, WT, DFF, 0, scr, lane);
            } else if (r < 9728) {
                r -= 8448; const int kb = r / 80, nb = r % 80;
                transpose_item(a.in[I_WIN] + (size_t)l * DM * INC, INC, kb * 64, nb * 32, (bf16_t*)(ws + WS_WIN) + (size_t)l * INC * DM, DM, 0, scr, lane);
            } else {
                r -= 9728; const int kb = r / 32, nb = r % 32;
                transpose_item(a.in[I_WOUT] + (size_t)l * DM * DM, DM, kb * 64, nb * 32, (bf16_t*)(ws + WS_WOUT) + (size_t)l * DM * DM, DM, 0, scr, lane);
            }
        }
        const float* wsrc = a.in[I_WS]; bf16_t* wdst = (bf16_t*)(ws + WS_WS);
        for (int i = (blockIdx.x * 512 + tid); i < DEPTH * 4 * 128 * 128 / 8; i += G * 512) {
            const f32x4 v0 = *(const f32x4*)(wsrc + (size_t)i * 8), v1 = *(const f32x4*)(wsrc + (size_t)i * 8 + 4);
            *(u32x4*)(wdst + (size_t)i * 8) = (u32x4){cvt_pk_bf16(v0[0], v0[1]), cvt_pk_bf16(v0[2], v0[3]), cvt_pk_bf16(v1[0], v1[1]), cvt_pk_bf16(v1[2], v1[3])};
        }
    }
    __syncthreads();
    {
        LAS float* sc = (LAS float*)lds;
        LAS float* red = (LAS float*)(lds + 9 * 1024 * 4);
        for (int i = tid; i < 9 * 1024; i += 512) { const int m = i >> 10, k = i & 1023; const float v = (m < 8) ? a.in[I_C][m * 1024 + k] : a.in[I_CCTX][k]; sc[i] = silu_f(v); }
        __syncthreads();
        float* MOD = (float*)(ws + WS_MOD);
        const int kq = tid >> 7, jj = tid & 127;
        for (int it = blockIdx.x; it < DEPTH * 72; it += G) {
            const int l = it / 72, cb = it % 72, col = cb * 128 + jj;
            const float* wp = a.in[I_WMOD] + (size_t)l * DM * 9216 + col;
            float acc[9];
#pragma unroll
            for (int m = 0; m < 9; ++m) acc[m] = 0.f;
#pragma unroll 4
            for (int k = kq * 256; k < kq * 256 + 256; ++k) {
                const float w = __builtin_nontemporal_load(wp + (size_t)k * 9216);
#pragma unroll
                for (int m = 0; m < 9; ++m) acc[m] += sc[m * 1024 + k] * w;
            }
#pragma unroll
            for (int m = 0; m < 9; ++m) red[(kq * 9 + m) * 128 + jj] = acc[m];
            __syncthreads();
            for (int o = tid; o < 9 * 128; o += 512) { const int m = o >> 7, j2 = o & 127;
                const float v = red[(0 * 9 + m) * 128 + j2] + red[(1 * 9 + m) * 128 + j2] + red[(2 * 9 + m) * 128 + j2] + red[(3 * 9 + m) * 128 + j2];
                MOD[((size_t)l * 9 + m) * 9216 + cb * 128 + j2] = v + a.in[I_BMOD][l * 9216 + cb * 128 + j2]; }
            __syncthreads();
        }
    }
    if (blockIdx.x == 0) {
        f32x2* rope = (f32x2*)(ws + WS_ROPE);
        for (int i = tid; i < 64 * 16; i += 512) { const int pos = i >> 4, j = i & 15; const float inv = powf(10000.0f, -(float)j / 16.0f); const float ang = (float)pos * inv; rope[i] = (f32x2){cosf(ang), sinf(ang)}; }
    }
    if (blockIdx.x == (G > 1 ? 1 : 0) && wave == 0) {
        float* LAM = (float*)(ws + WS_LAM);
        for (int l = 0; l < DEPTH; ++l) {
            const float* lp = a.in[I_LAM] + l * 256;
            const float s1 = wave_sum(lp[lane] * lp[64 + lane]), s2 = wave_sum(lp[128 + lane] * lp[192 + lane]);
            const float lam_init = 0.8f - 0.6f * expf(-0.3f * (float)l);
            if (lane == 0) { LAM[l] = expf(s1) - expf(s2) + lam_init; LAM[4 + l] = 1.0f - lam_init; }
        }
    }
}

__device__ __forceinline__ void unpack8(const u32x4 w, f32x4& lo, f32x4& hi) {
    lo = (f32x4){__uint_as_float(w.x << 16), __uint_as_float(w.x & 0xffff0000u), __uint_as_float(w.y << 16), __uint_as_float(w.y & 0xffff0000u)};
    hi = (f32x4){__uint_as_float(w.z << 16), __uint_as_float(w.z & 0xffff0000u), __uint_as_float(w.w << 16), __uint_as_float(w.w & 0xffff0000u)};
}
__device__ __forceinline__ void norm_phase(const Args& a, LAS unsigned char* lds, int l, int j, int l2, int j2, int nrows, float wgt, int tid, int G) {
    const int lane = tid & 63, wave = tid >> 6;
    unsigned char* ws = a.ws;
    const float* MOD = (const float*)(ws + WS_MOD);
    const bf16_t* Z = (const bf16_t*)(ws + WS_Z);
    bf16_t* S16 = (bf16_t*)(ws + WS_S16);
    bf16_t* Y = (bf16_t*)(ws + WS_Y);
    const int NW = G * 8, gw = blockIdx.x * 8 + wave;
    const int lc = (T_LAT + NW - 1) / NW, cc = (nrows > T_LAT) ? (nrows - T_LAT + NW - 1) / NW : 0;
    const int la = gw * lc < T_LAT ? gw * lc : T_LAT, lb = (la + lc < T_LAT) ? la + lc : T_LAT;
    const int ca0 = T_LAT + gw * cc, ca = ca0 < nrows ? ca0 : nrows, cb = (ca + cc < nrows) ? ca + cc : nrows;
    const int nmine = (lb - la) + (cb - ca);
#define NORM_ROW(i_) ((i_) < lb - la ? la + (i_) : ca + ((i_) - (lb - la)))
    const int cl = 8 * lane;
    const int mfirst = ((int)blockIdx.x * 8 * lc) >> 11, mlastr = ((int)blockIdx.x * 8 + 7) * lc + lc - 1, mlast = (mlastr < T_LAT ? mlastr : T_LAT - 1) >> 11;
    const bool use_lds = (mfirst == mlast) && ((int)blockIdx.x * 8 * lc < T_LAT);
    LAS f32x4* vlds = (LAS f32x4*)lds;
    if (use_lds) {
        const int set = tid >> 8, c4 = tid & 255, mm = set ? 8 : mfirst, c = 4 * c4;
        float z0_ = 0.f; asm volatile("" : "+v"(z0_));
        f32x4 av = (f32x4){z0_, z0_, z0_, z0_}, bv = av, cv = av;
        if (l >= 0) av = *(const f32x4*)(MOD + ((size_t)l * 9 + mm) * 9216 + (3 * j + 2) * DM + c) * *(const f32x4*)(a.in[I_NPOST] + (size_t)(l * 3 + j) * DM + c) * wgt;
        if (l2 < DEPTH) { const float* shift = MOD + ((size_t)l2 * 9 + mm) * 9216 + (3 * j2) * DM;
            bv = *(const f32x4*)(a.in[I_NPRE] + (size_t)(l2 * 3 + j2) * DM + c) * (*(const f32x4*)(shift + DM + c) + 1.0f); cv = *(const f32x4*)(shift + c); }
        vlds[(set * 3 + 0) * 256 + c4] = av; vlds[(set * 3 + 1) * 256 + c4] = bv; vlds[(set * 3 + 2) * 256 + c4] = cv;
    }
    __syncthreads();
    const bool final_out = (l2 >= DEPTH);
    int mcur = -1;
    f32x4 Av[4], Bv[4], Cv[4];
#pragma unroll
    for (int k = 0; k < 4; ++k) { Av[k] = (f32x4){0.f, 0.f, 0.f, 0.f}; Bv[k] = Av[k]; Cv[k] = Av[k]; }
    u32x4 zc0 = (u32x4){0u, 0u, 0u, 0u}, zc1 = zc0, qc0 = zc0, qc1 = zc0; f32x4 xc[4];
#pragma unroll
    for (int k = 0; k < 4; ++k) xc[k] = (f32x4){0.f, 0.f, 0.f, 0.f};
#define NORM_LOAD(row_, z0_, z1_, q0_, q1_, x_) do { \
        if (l < 0) { const float* src_ = ((row_) < T_LAT) ? a.in[I_X] + (size_t)(row_) * DM : a.in[I_CTX] + (size_t)((row_) - T_LAT) * DM; \
            _Pragma("unroll") for (int k = 0; k < 4; ++k) x_[k] = __builtin_nontemporal_load((const f32x4*)(src_ + 512 * (k >> 1) + cl + 4 * (k & 1))); } \
        else { z0_ = __builtin_nontemporal_load((const u32x4*)(Z + (size_t)(row_) * DM + cl)); z1_ = __builtin_nontemporal_load((const u32x4*)(Z + (size_t)(row_) * DM + 512 + cl)); \
            q0_ = __builtin_nontemporal_load((const u32x4*)(S16 + (size_t)(row_) * DM + cl)); q1_ = __builtin_nontemporal_load((const u32x4*)(S16 + (size_t)(row_) * DM + 512 + cl)); } } while (0)
    if (nmine > 0) NORM_LOAD(NORM_ROW(0), zc0, zc1, qc0, qc1, xc);
    for (int ri = 0; ri < nmine; ++ri) {
        const int row = NORM_ROW(ri);
        const bool lat = row < T_LAT;
        const int m = lat ? (row >> 11) : 8;
        u32x4 zn0 = zc0, zn1 = zc1, qn0 = qc0, qn1 = qc1; f32x4 xn[4];
#pragma unroll
        for (int k = 0; k < 4; ++k) xn[k] = xc[k];
        if (ri + 1 < nmine) { const int rown = NORM_ROW(ri + 1); NORM_LOAD(rown, zn0, zn1, qn0, qn1, xn); }
        if (m != mcur && use_lds) {
            mcur = m;
            const int set = (m == 8) ? 1 : 0;
#pragma unroll
            for (int k = 0; k < 4; ++k) { const int c4 = (512 * (k >> 1) + cl + 4 * (k & 1)) >> 2; Av[k] = vlds[(set * 3 + 0) * 256 + c4]; Bv[k] = vlds[(set * 3 + 1) * 256 + c4]; Cv[k] = vlds[(set * 3 + 2) * 256 + c4]; }
        }
        if (m != mcur) {
            mcur = m;
            if (l >= 0) {
                const float* gate = MOD + ((size_t)l * 9 + m) * 9216 + (3 * j + 2) * DM;
                const float* post = a.in[I_NPOST] + (size_t)(l * 3 + j) * DM;
#pragma unroll
                for (int k = 0; k < 4; ++k) { const int c = 512 * (k >> 1) + cl + 4 * (k & 1); Av[k] = *(const f32x4*)(gate + c) * *(const f32x4*)(post + c) * wgt; }
            }
            if (l2 < DEPTH) {
                const float* shift = MOD + ((size_t)l2 * 9 + m) * 9216 + (3 * j2) * DM;
                const float* scale = shift + DM;
                const float* pre = a.in[I_NPRE] + (size_t)(l2 * 3 + j2) * DM;
#pragma unroll
                for (int k = 0; k < 4; ++k) { const int c = 512 * (k >> 1) + cl + 4 * (k & 1); Bv[k] = *(const f32x4*)(pre + c) * (*(const f32x4*)(scale + c) + 1.0f); Cv[k] = *(const f32x4*)(shift + c); }
            }
        }
        f32x4 sv[4];
        if (l < 0) {
#pragma unroll
            for (int k = 0; k < 4; ++k) sv[k] = xc[k];
        } else {
            unpack8(qc0, sv[0], sv[1]); unpack8(qc1, sv[2], sv[3]);
            f32x4 zv[4];
            unpack8(zc0, zv[0], zv[1]); unpack8(zc1, zv[2], zv[3]);
            if (!lat) {
#pragma unroll
                for (int pp = 1; pp < 8; ++pp) { const bf16_t* zp = Z + (size_t)(row + pp * T_CTX) * DM + cl; f32x4 t0, t1, t2, t3;
                    unpack8(*(const u32x4*)zp, t0, t1); unpack8(*(const u32x4*)(zp + 512), t2, t3); zv[0] += t0; zv[1] += t1; zv[2] += t2; zv[3] += t3; }
            }
            float ss = 0.f;
#pragma unroll
            for (int k = 0; k < 4; ++k) ss += (zv[k][0] * zv[k][0] + zv[k][1] * zv[k][1]) + (zv[k][2] * zv[k][2] + zv[k][3] * zv[k][3]);
            ss = wave_sum(ss);
            const float rstd = rsqrtf(ss * (1.0f / DM) + EPSV);
#pragma unroll
            for (int k = 0; k < 4; ++k) sv[k] += Av[k] * (zv[k] * rstd);
        }
        if (final_out) {
            float* orow = a.out + (size_t)row * DM;
#pragma unroll
            for (int k = 0; k < 4; ++k) *(f32x4*)(orow + 512 * (k >> 1) + cl + 4 * (k & 1)) = sv[k];
        } else {
            __builtin_nontemporal_store((u32x4){cvt_pk_bf16(sv[0][0], sv[0][1]), cvt_pk_bf16(sv[0][2], sv[0][3]), cvt_pk_bf16(sv[1][0], sv[1][1]), cvt_pk_bf16(sv[1][2], sv[1][3])}, (u32x4*)(S16 + (size_t)row * DM + cl));
            __builtin_nontemporal_store((u32x4){cvt_pk_bf16(sv[2][0], sv[2][1]), cvt_pk_bf16(sv[2][2], sv[2][3]), cvt_pk_bf16(sv[3][0], sv[3][1]), cvt_pk_bf16(sv[3][2], sv[3][3])}, (u32x4*)(S16 + (size_t)row * DM + 512 + cl));
        }
        if (l2 < DEPTH) {
            float ss = 0.f;
#pragma unroll
            for (int k = 0; k < 4; ++k) ss += (sv[k][0] * sv[k][0] + sv[k][1] * sv[k][1]) + (sv[k][2] * sv[k][2] + sv[k][3] * sv[k][3]);
            ss = wave_sum(ss);
            const float rstd = rsqrtf(ss * (1.0f / DM) + EPSV);
            f32x4 y[4];
#pragma unroll
            for (int k = 0; k < 4; ++k) y[k] = (sv[k] * rstd) * Bv[k] + Cv[k];
            *(u32x4*)(Y + (size_t)row * DM + cl) = (u32x4){cvt_pk_bf16(y[0][0], y[0][1]), cvt_pk_bf16(y[0][2], y[0][3]), cvt_pk_bf16(y[1][0], y[1][1]), cvt_pk_bf16(y[1][2], y[1][3])};
            *(u32x4*)(Y + (size_t)row * DM + 512 + cl) = (u32x4){cvt_pk_bf16(y[2][0], y[2][1]), cvt_pk_bf16(y[2][2], y[2][3]), cvt_pk_bf16(y[3][0], y[3][1]), cvt_pk_bf16(y[3][2], y[3][3])};
        }
        zc0 = zn0; zc1 = zn1; qc0 = qn0; qc1 = qn1;
#pragma unroll
        for (int k = 0; k < 4; ++k) xc[k] = xn[k];
    }
#undef NORM_LOAD
#undef NORM_ROW
}

template <int NMAP, int VD, bool SWA>
__device__ __forceinline__ void attn_unit(LAS unsigned char* lds, const bf16_t* __restrict__ Qp, int qpitch, const bf16_t* __restrict__ Kb, const bf16_t* __restrict__ Vt,
                                          int n0, int t1lo, int t1hi, int qp0, float sink_l2, float lam, const float* __restrict__ gsub, float post_scale, bf16_t* __restrict__ Op, int tid) {
    constexpr int KW = SWA ? 64 : 64 * NMAP, KMS = SWA ? 0 : 64, KP = 144, VP = 144, NKC = KW / 64, NVC = VD / 64, NET = VD / 16;
    constexpr int KBYTES = 64 * KP * 2, BUFB = KBYTES + 64 * VP * 2;
    const int lane = tid & 63, w = tid >> 6, fr = lane & 15, fq = lane >> 4;
    bf16x8 qf[NMAP][2];
    { const bf16_t* qr = Qp + (size_t)(16 * w + fr) * qpitch + fq * 8;
#pragma unroll
      for (int mp = 0; mp < NMAP; ++mp)
#pragma unroll
          for (int ks = 0; ks < 2; ++ks) qf[mp][ks] = *(const bf16x8*)(qr + mp * 64 + ks * 32); }
    f32x4 oacc[NMAP][NET], negm[NMAP]; float mrun[NMAP], lsum[NMAP];
#pragma unroll
    for (int mp = 0; mp < NMAP; ++mp) { mrun[mp] = 0.f; lsum[mp] = 0.f; negm[mp] = (f32x4){0.f, 0.f, 0.f, 0.f};
#pragma unroll
        for (int et = 0; et < NET; ++et) oacc[mp][et] = (f32x4){0.f, 0.f, 0.f, 0.f}; }
    const int ntiles = n0 + (t1hi - t1lo);
    u32x4 kreg[NKC], vreg[NVC];
#define ATT_TILE(i) ((i) < n0 ? (i) : t1lo + ((i) - n0))
#define ATT_LOAD(tile) do { const int k0_ = (tile) * 64; \
        _Pragma("unroll") for (int i_ = 0; i_ < NKC; ++i_) { const int c_ = tid + 512 * i_, key_ = c_ / (KW / 8), cc_ = c_ % (KW / 8); kreg[i_] = *(const u32x4*)(Kb + (size_t)(k0_ + key_) * KW + cc_ * 8); } \
        _Pragma("unroll") for (int i_ = 0; i_ < NVC; ++i_) { const int c_ = tid + 512 * i_, key_ = c_ / (VD / 8), cc_ = c_ % (VD / 8); vreg[i_] = *(const u32x4*)(Vt + (size_t)(k0_ + key_) * VD + cc_ * 8); } } while (0)
#define ATT_STORE(buf) do { LAS bf16_t* kS_ = (LAS bf16_t*)(lds + (buf) * BUFB); LAS bf16_t* vS_ = (LAS bf16_t*)(lds + (buf) * BUFB + KBYTES); \
        _Pragma("unroll") for (int i_ = 0; i_ < NKC; ++i_) { const int c_ = tid + 512 * i_, key_ = c_ / (KW / 8), cc_ = c_ % (KW / 8); *(LAS u32x4*)(kS_ + key_ * KP + cc_ * 8) = kreg[i_]; } \
        _Pragma("unroll") for (int i_ = 0; i_ < NVC; ++i_) { const int c_ = tid + 512 * i_, key_ = c_ / (VD / 8), cc_ = c_ % (VD / 8); *(LAS u32x4*)(vS_ + key_ * VP + cc_ * 8) = vreg[i_]; } } while (0)
    ATT_LOAD(ATT_TILE(0));
    ATT_STORE(0);
    if (ntiles > 1) ATT_LOAD(ATT_TILE(1));
    __syncthreads();
    for (int i = 0; i < ntiles; ++i) {
        const int t = ATT_TILE(i);
        if (i + 1 < ntiles) { ATT_STORE((i + 1) & 1); if (i + 2 < ntiles) ATT_LOAD(ATT_TILE(i + 2)); }
        const LAS bf16_t* kS = (const LAS bf16_t*)(lds + (i & 1) * BUFB);
        const LAS bf16_t* vS = (const LAS bf16_t*)(lds + (i & 1) * BUFB + KBYTES);
        bf16x8 pf[NMAP][2];
        f32x4 sacc[NMAP][4];
#pragma unroll
        for (int mp = 0; mp < NMAP; ++mp) {
            bf16x8 kf[4][2];
#pragma unroll
            for (int kt = 0; kt < 4; ++kt)
#pragma unroll
                for (int ks = 0; ks < 2; ++ks) kf[kt][ks] = *(const LAS bf16x8*)(kS + (16 * kt + fr) * KP + mp * KMS + ks * 32 + fq * 8);
            __builtin_amdgcn_sched_barrier(0);
#pragma unroll
            for (int kt = 0; kt < 4; ++kt) sacc[mp][kt] = __builtin_amdgcn_mfma_f32_16x16x32_bf16(kf[kt][0], qf[mp][0], negm[mp], 0, 0, 0);
#pragma unroll
            for (int kt = 0; kt < 4; ++kt) sacc[mp][kt] = __builtin_amdgcn_mfma_f32_16x16x32_bf16(kf[kt][1], qf[mp][1], sacc[mp][kt], 0, 0, 0);
        }
        bf16x8 va[4];
#define ATT_LDV(dst, idx) do { const LAS bf16_t* vp_ = vS + (32 * ((idx) / NET) + 4 * fq + (fr >> 2)) * VP + 16 * ((idx) % NET) + 4 * (fr & 3); \
            const s16x4 lo_ = __builtin_amdgcn_ds_read_tr16_b64_v4i16((LAS s16x4*)vp_), hi_ = __builtin_amdgcn_ds_read_tr16_b64_v4i16((LAS s16x4*)(vp_ + 16 * VP)); \
            dst = (bf16x8){lo_[0], lo_[1], lo_[2], lo_[3], hi_[0], hi_[1], hi_[2], hi_[3]}; } while (0)
#pragma unroll
        for (int i2 = 0; i2 < 4; ++i2) ATT_LDV(va[i2], i2);
        if (SWA && t >= 4) {
            const int dq = qp0 + 16 * w + fr - (64 * (t - 4) + 4 * fq);
#pragma unroll
            for (int kt = 0; kt < 4; ++kt)
#pragma unroll
                for (int r = 0; r < 4; ++r) { const int d = dq - 16 * kt - r; if (d > 128 || d < -128) {
#pragma unroll
                    for (int mp = 0; mp < NMAP; ++mp) sacc[mp][kt][r] = -INFINITY; } }
        }
        float mx[NMAP];
#pragma unroll
        for (int mp = 0; mp < NMAP; ++mp) {
            float v = fmax2(fmax2(sacc[mp][0][0], sacc[mp][0][1]), fmax2(sacc[mp][0][2], sacc[mp][0][3]));
#pragma unroll
            for (int kt = 1; kt < 4; ++kt) v = fmax2(v, fmax2(fmax2(sacc[mp][kt][0], sacc[mp][kt][1]), fmax2(sacc[mp][kt][2], sacc[mp][kt][3])));
            mx[mp] = v;
        }
#pragma unroll
        for (int mp = 0; mp < NMAP; ++mp) mx[mp] = fmax2(mx[mp], __shfl_xor(mx[mp], 16));
#pragma unroll
        for (int mp = 0; mp < NMAP; ++mp) mx[mp] = fmax2(mx[mp], __shfl_xor(mx[mp], 32));
#pragma unroll
        for (int mp = 0; mp < NMAP; ++mp) {
            if (i == 0 || __builtin_amdgcn_ballot_w64(mx[mp] > 8.0f) != 0ull) {
                const float delta = (i == 0) ? mx[mp] : fmaxf(mx[mp], 0.f), alpha = (i == 0) ? 0.f : __builtin_amdgcn_exp2f(-delta);
                mrun[mp] += delta; negm[mp] = (f32x4){-mrun[mp], -mrun[mp], -mrun[mp], -mrun[mp]}; lsum[mp] *= alpha;
#pragma unroll
                for (int kt = 0; kt < 4; ++kt) sacc[mp][kt] = sacc[mp][kt] - delta;
#pragma unroll
                for (int et = 0; et < NET; ++et) oacc[mp][et] = oacc[mp][et] * alpha;
            }
            float ps = 0.f;
#pragma unroll
            for (int kt = 0; kt < 4; ++kt)
#pragma unroll
                for (int r = 0; r < 4; ++r) { const float p = __builtin_amdgcn_exp2f(sacc[mp][kt][r]); sacc[mp][kt][r] = p; ps += p; }
            lsum[mp] += ps;
#pragma unroll
            for (int s2 = 0; s2 < 2; ++s2) {
                u32x4 pk; pk.x = cvt_pk_bf16(sacc[mp][2 * s2][0], sacc[mp][2 * s2][1]); pk.y = cvt_pk_bf16(sacc[mp][2 * s2][2], sacc[mp][2 * s2][3]);
                pk.z = cvt_pk_bf16(sacc[mp][2 * s2 + 1][0], sacc[mp][2 * s2 + 1][1]); pk.w = cvt_pk_bf16(sacc[mp][2 * s2 + 1][2], sacc[mp][2 * s2 + 1][3]);
                pf[mp][s2] = __builtin_bit_cast(bf16x8, pk);
            }
        }
#pragma unroll
        for (int idx = 0; idx < 2 * NET; ++idx) {
            const int et = idx % NET, s2 = idx / NET;
            const bf16x8 cur = va[idx & 3];
            if (idx + 4 < 2 * NET) ATT_LDV(va[idx & 3], idx + 4);
#pragma unroll
            for (int mp = 0; mp < NMAP; ++mp) oacc[mp][et] = __builtin_amdgcn_mfma_f32_16x16x32_bf16(cur, pf[mp][s2], oacc[mp][et], 0, 0, 0);
        }
#undef ATT_LDV
        __syncthreads();
    }
#undef ATT_TILE
#undef ATT_LOAD
#undef ATT_STORE
    float lt[NMAP];
#pragma unroll
    for (int mp = 0; mp < NMAP; ++mp) { float v = lsum[mp]; v += __shfl_xor(v, 16); v += __shfl_xor(v, 32); lt[mp] = v; }
    bf16_t* orow = Op + (size_t)(16 * w + fr) * DM + 4 * fq;
    if constexpr (!SWA) {
        const float inv0 = 1.0f / lt[0], inv1 = lam / lt[1];
        float ss = 0.f;
#pragma unroll
        for (int et = 0; et < NET; ++et)
#pragma unroll
            for (int r = 0; r < 4; ++r) { const float o = oacc[0][et][r] * inv0 - oacc[1][et][r] * inv1; oacc[0][et][r] = o; ss += o * o; }
        ss += __shfl_xor(ss, 16); ss += __shfl_xor(ss, 32);
        const float rstd = rsqrtf(ss * (1.0f / VD) + EPSV) * post_scale;
#pragma unroll
        for (int et = 0; et < NET; ++et) { const f32x4 g = *(const f32x4*)(gsub + 16 * et + 4 * fq); const f32x4 v = oacc[0][et] * rstd * g;
            *(u32x2*)(orow + 16 * et) = (u32x2){cvt_pk_bf16(v[0], v[1]), cvt_pk_bf16(v[2], v[3])}; }
    } else {
#pragma unroll
        for (int mp = 0; mp < NMAP; ++mp) {
            const float l0 = lt[mp] + __builtin_amdgcn_exp2f((mp == 0 ? sink_l2 : lam) - mrun[mp]);
            const float inv = 1.0f / l0;
#pragma unroll
            for (int et = 0; et < NET; ++et) { const f32x4 v = oacc[mp][et] * inv; *(u32x2*)(orow + mp * 64 + 16 * et) = (u32x2){cvt_pk_bf16(v[0], v[1]), cvt_pk_bf16(v[2], v[3])}; }
        }
    }
    __syncthreads();
}

__device__ __forceinline__ void gmlp_unit(LAS unsigned char* lds, const bf16_t* __restrict__ UV, const bf16_t* __restrict__ Wsb  , const float* __restrict__ gain  ,
                                          const float* __restrict__ bs  , int r0, int h, bf16_t* __restrict__ O, int tid) {
    constexpr int VP = 136;
    LAS bf16_t* vT = (LAS bf16_t*)lds;
    const int lane = tid & 63, w = tid >> 6, fr = lane & 15, fq = lane >> 4;
    {
        const int q = tid >> 2, part = tid & 3;
        const bf16_t* src = UV + (size_t)(r0 + q) * 512 + 256 + 64 * h + 16 * part;
        const u32x4 a0 = *(const u32x4*)src, a1 = *(const u32x4*)(src + 8);
        float v[16];
#pragma unroll
        for (int i = 0; i < 4; ++i) { v[2 * i] = __uint_as_float(a0[i] << 16); v[2 * i + 1] = __uint_as_float(a0[i] & 0xffff0000u); v[8 + 2 * i] = __uint_as_float(a1[i] << 16); v[8 + 2 * i + 1] = __uint_as_float(a1[i] & 0xffff0000u); }
        float ss = 0.f;
#pragma unroll
        for (int i = 0; i < 16; ++i) ss += v[i] * v[i];
        ss += __shfl_xor(ss, 1); ss += __shfl_xor(ss, 2);
        const float rstd = rsqrtf(ss * (1.0f / 64.0f) + EPSV);
#pragma unroll
        for (int i = 0; i < 16; ++i) { const int c = 16 * part + i; vT[c * VP + q] = (bf16_t)(cvt_pk_bf16(v[i] * rstd * gain[c], 0.f) & 0xffffu); }
    }
    __syncthreads();
    f32x4 acc[4];
#pragma unroll
    for (int nt = 0; nt < 4; ++nt) acc[nt] = (f32x4){0.f, 0.f, 0.f, 0.f};
#pragma unroll
    for (int ks = 0; ks < 4; ++ks) {
        const bf16x8 wf = *(const bf16x8*)(Wsb + (size_t)(16 * w + fr) * 128 + 32 * ks + 8 * fq);
#pragma unroll
        for (int nt = 0; nt < 4; ++nt) { const bf16x8 vf = *(const LAS bf16x8*)(vT + (16 * nt + fr) * VP + 32 * ks + 8 * fq);
            acc[nt] = __builtin_amdgcn_mfma_f32_16x16x32_bf16(vf, wf, acc[nt], 0, 0, 0); }
    }
    const int p = 16 * w + fr; const float bias = bs[p];
    const bf16_t* up = UV + (size_t)(r0 + p) * 512 + 64 * h + 4 * fq;
    bf16_t* op = O + (size_t)(r0 + p) * DM + 64 * h + 4 * fq;
#pragma unroll
    for (int nt = 0; nt < 4; ++nt) {
        const u32x2 uu = *(const u32x2*)(up + 16 * nt);
        const float u0 = __uint_as_float(uu.x << 16), u1 = __uint_as_float(uu.x & 0xffff0000u), u2 = __uint_as_float(uu.y << 16), u3 = __uint_as_float(uu.y & 0xffff0000u);
        *(u32x2*)(op + 16 * nt) = (u32x2){cvt_pk_bf16(u0 * (acc[nt][0] + bias), u1 * (acc[nt][1] + bias)), cvt_pk_bf16(u2 * (acc[nt][2] + bias), u3 * (acc[nt][3] + bias))};
    }
    __syncthreads();
}

__device__ __forceinline__ void mix_phase(const Args& a, LAS unsigned char* lds, int l, int tid_in, int G) {
    unsigned char* ws = a.ws;
    const bool last = (l == DEPTH - 1);
    const bf16_t* UV = (const bf16_t*)(ws + R1_UV); const bf16_t* QB = (const bf16_t*)(ws + R1_QB); const bf16_t* QC = (const bf16_t*)(ws + R1_QC);
    const bf16_t* KB = (const bf16_t*)(ws + R1_KB); const bf16_t* VBt = (const bf16_t*)(ws + R1_VB); const bf16_t* KC = (const bf16_t*)(ws + R1_KC); const bf16_t* VCt = (const bf16_t*)(ws + R1_VC);
    bf16_t* O = (bf16_t*)(ws + R1_O);
    const float* LAM = (const float*)(ws + WS_LAM);
    const float lam = LAM[l], post_scale = LAM[4 + l];
    const float* gsub = a.in[I_SUBLN] + l * 128;
    const int n_ctxd = last ? 0 : 64, n_ctxs = last ? 0 : 32, n_g = last ? 512 : 576;
    const int e0 = 512, e1 = e0 + 256, e2 = e1 + n_ctxd, e3 = e2 + n_ctxs, e4 = e3 + n_g;
    for (int u = blockIdx.x; u < e4; u += G) {
        int tid = tid_in; asm volatile("" : "+v"(tid));
        if (u < e3) {
            const bool is_swa = (u >= e0 && u < e1) || (u >= e2);
            const bool is_ctx = (u >= e1);
            int b, hh, qb, row0;
            if (u < e0) {
                const int v = u, x = v & 7, slot = (v >> 3) & 31, rnd = v >> 8, P = x * 4 + rnd * 2 + (slot >> 4);
                b = P >> 2; hh = P & 3; qb = slot & 15; row0 = b * SEQ + 128 * qb; }
            else if (u < e1) { const int v = u - e0, x = v & 7, slot = (v >> 3) & 31, P = x * 2 + (slot >> 4); b = P >> 1; hh = P & 1; qb = slot & 15; row0 = b * SEQ + 128 * qb; }
            else if (u < e2) { const int v = u - e1; b = v >> 3; hh = (v >> 1) & 3; qb = v & 1; row0 = T_LAT + b * CTXL + 128 * qb; }
            else { const int v = u - e2; b = v >> 2; hh = (v >> 1) & 1; qb = v & 1; row0 = T_LAT + b * CTXL + 128 * qb; }
            if (!is_swa) {
                attn_unit<2, 128, false>(lds, QB + (size_t)row0 * 512 + hh * 128, 512, KB + (size_t)(b * 4 + hh) * NKEY * 128, VBt + (size_t)(b * 4 + hh) * NKEY * 128,
                                         is_ctx ? 4 : 36, 0, 0, 0, 0.f, lam, gsub, post_scale, O + (size_t)row0 * DM + 256 + hh * 128, tid);
            } else {
                const int kv = hh;
                int lo = 4 + 2 * (qb - 1), hi = 4 + 2 * (qb + 2); if (lo < 4) lo = 4; if (hi > 36) hi = 36;
                if (is_ctx) { lo = 0; hi = 0; }
                attn_unit<2, 64, true>(lds, QC + (size_t)row0 * 256 + kv * 128, 256, KC + (size_t)(b * 2 + kv) * NKEY * 64, VCt + (size_t)(b * 2 + kv) * NKEY * 64,
                                       4, lo, hi, 128 * qb, a.in[I_SINK][l * 4 + kv * 2] * LOG2E, a.in[I_SINK][l * 4 + kv * 2 + 1] * LOG2E, nullptr, 0.f, O + (size_t)row0 * DM + 768 + kv * 128, tid);
            }
        } else {
            const int v = u - e3, ch = v >> 2, h = v & 3;
            gmlp_unit(lds, UV, (const bf16_t*)(ws + WS_WS) + (size_t)(l * 4 + h) * 128 * 128, a.in[I_VGAIN] + (l * 4 + h) * 64, a.in[I_BS] + (l * 4 + h) * 128, ch * 128, h, O, tid);
        }
    }
}

__global__ void __launch_bounds__(512, 2) mega_fwd(Args a) {
    extern __shared__ __attribute__((aligned(16))) unsigned char lds_raw[];
    LAS unsigned char* lds = (LAS unsigned char*)lds_raw;
    cg::grid_group grid = cg::this_grid();
    const int G = gridDim.x;
    volatile LAS unsigned* MISC = (volatile LAS unsigned*)(lds + 131072);
    if (threadIdx.x < 64) MISC[threadIdx.x] = 0u;
    __syncthreads();
    const XcdBarrier xbar = xcd_barrier_post((unsigned*)a.ws, MISC + 8);
    for (int p = a.ph_lo; p < a.ph_hi; ++p) {
        int tid = threadIdx.x; asm volatile("" : "+v"(tid));
        unsigned char* ws = a.ws; asm volatile("" : "+s"(ws));
        if (p == 0) prologue_a(a, lds, tid, G);
        else if (p == 1) norm_phase(a, lds, -1, 0, 0, 0, TT, 0.f, tid, G);
        else {
            const int q = p - 2, l = q / 10, st = q % 10; const bool last = (l == DEPTH - 1);
            const int Mfull = TT, Mlate = last ? T_LAT : TT;
            if (st == 0 || st == 7) {
                const int sub = (st == 7), M = sub ? Mlate : Mfull;
                pg8::Gemm g{(const bf16_t*)(ws + WS_Y), (const bf16_t*)(ws + WS_WGU) + (size_t)(l * 2 + sub) * NGU * DM, M, NGU, DM};
                pg8::StaticOrder S; S.init(M, NGU, G, (int)blockIdx.x); S.nkt = DM / pg8::BK;
                pg8::EpiSwiGLU E{(bf16_t*)(ws + WS_R1)};
                pg8::gemm_phase<pg8::EpiSwiGLU, pg8::StaticOrder, true, true>(lds, g, S, E, tid);
            } else if (st == 1 || st == 8 || st == 5) {
                pg8::Gemm g; int M;
                if (st == 5) { M = Mlate; g = pg8::Gemm{(const bf16_t*)(ws + R1_O), (const bf16_t*)(ws + WS_WOUT) + (size_t)l * DM * DM, M, DM, DM}; }
                else { const int sub = (st == 8); M = sub ? Mlate : Mfull; g = pg8::Gemm{(const bf16_t*)(ws + WS_R1), (const bf16_t*)(ws + WS_WD) + (size_t)(l * 2 + sub) * DM * DFF, M, DM, DFF}; }
                pg8::SplitOrder S; S.init(M, g.K, G, (int)blockIdx.x);
                pg8::EpiZ16 E{(bf16_t*)(ws + WS_Z)};
                pg8::gemm_phase<pg8::EpiZ16, pg8::SplitOrder, true, true>(lds, g, S, E, tid);
            } else if (st == 3) {
                pg8::Gemm g{(const bf16_t*)(ws + WS_Y), (const bf16_t*)(ws + WS_WIN) + (size_t)l * INC * DM, Mfull, INC, DM};
                pg8::StaticOrder S; S.init(Mfull, INC, G, (int)blockIdx.x); S.nkt = DM / pg8::BK;
                pg8::EpiInProj E{(bf16_t*)(ws + R1_UV), (bf16_t*)(ws + R1_QB), (bf16_t*)(ws + R1_QC), (bf16_t*)(ws + R1_KB), (bf16_t*)(ws + R1_VB), (bf16_t*)(ws + R1_KC), (bf16_t*)(ws + R1_VC), (const f32x2*)(ws + WS_ROPE)};
                pg8::gemm_phase<pg8::EpiInProj, pg8::StaticOrder, true, true>(lds, g, S, E, tid);
            } else if (st == 4) {
                mix_phase(a, lds, l, tid, G);
            } else {
                const int j = (st == 2) ? 0 : (st == 6 ? 1 : 2);
                const int l2 = (j == 2) ? l + 1 : l, j2 = (j == 2) ? 0 : j + 1;
                const int nrows = (j == 0) ? Mfull : Mlate;
                norm_phase(a, lds, l, j, l2, j2, nrows, (j == 1) ? 1.0f : 0.5f, tid, G);
            }
        }
        if (p + 1 < a.ph_hi) { if (a.ph_hi > NPHASE) grid.sync(); else xcd_barrier(xbar); }
    }
}

extern "C" void kernel_launch(void* const* d_in, const int* in_sizes, int n_in, void* d_out, int out_size, void* d_ws, size_t ws_size, hipStream_t stream) {
    static int grid = 0;
    if (grid == 0) {
        if (n_in != 19 || out_size != T_LAT * DM || ws_size < WS_NEED) { fprintf(stderr, "kernel_launch: unexpected shapes (n_in %d out %d ws %zu)\n", n_in, out_size, ws_size); grid = -1; return; }
        int dev = 0, cus = 0, per_cu = 0;
        (void)hipGetDevice(&dev);
        (void)hipDeviceGetAttribute(&cus, hipDeviceAttributeMultiprocessorCount, dev);
        if (hipFuncSetAttribute((const void*)mega_fwd, hipFuncAttributeMaxDynamicSharedMemorySize, LDS_BYTES) != hipSuccess) { fprintf(stderr, "kernel_launch: hipFuncSetAttribute failed\n"); grid = -1; return; }
        if (hipOccupancyMaxActiveBlocksPerMultiprocessor(&per_cu, (const void*)mega_fwd, 512, LDS_BYTES) != hipSuccess || per_cu < 1) { fprintf(stderr, "kernel_launch: occupancy query gave %d\n", per_cu); per_cu = 1; }
        (void)hipGetLastError();
        grid = cus * 1;
        if (grid <= 0) grid = 256;
    }
    if (grid < 0) return;
    (void)hipMemsetAsync(d_ws, 0, 65536, stream);
    Args a{};
    for (int i = 0; i < 19; ++i) a.in[i] = (const float*)d_in[i];
    a.out = (float*)d_out; a.ws = (unsigned char*)d_ws; a.ph_lo = 0; a.ph_hi = NPHASE;
    void* args[] = {&a};
    hipError_t e = hipLaunchCooperativeKernel((const void*)mega_fwd, dim3(grid), dim3(512), args, LDS_BYTES, stream);
    if (e != hipSuccess) fprintf(stderr, "kernel_launch: cooperative launch failed: %s (grid %d)\n", hipGetErrorString(e), grid);
}
```

```cpp
#include <hip/hip_runtime.h>
#include <hip/hip_cooperative_groups.h>
#include <cstdio>
#include <cstdint>
namespace cg = cooperative_groups;

#define LAS __attribute__((address_space(3)))
typedef unsigned short bf16_t;
typedef short bf16x8 __attribute__((ext_vector_type(8)));
typedef short s16x4 __attribute__((ext_vector_type(4)));
typedef float f32x4 __attribute__((ext_vector_type(4)));
typedef float f32x2 __attribute__((ext_vector_type(2)));
typedef unsigned u32x4 __attribute__((ext_vector_type(4)));
typedef unsigned u32x2 __attribute__((ext_vector_type(2)));

constexpr int DM = 1024, NB = 8, SEQ = 2048, CTXL = 256, DEPTH = 4, DFF = 2816, NGU = 2 * DFF, INC = 2560, NKEY = SEQ + CTXL;
constexpr int T_LAT = NB * SEQ, T_CTX = NB * CTXL, TT = T_LAT + T_CTX;
constexpr float EPSV = 1e-6f;
constexpr float QSCALE = 0.125f * 1.4426950408889634f;
constexpr float LOG2E = 1.4426950408889634f;

constexpr size_t MiB = 1u << 20;
constexpr size_t WS_MOD = 1 * MiB;
constexpr size_t WS_ROPE = 3 * MiB;
constexpr size_t WS_LAM = 3 * MiB + 65536;
constexpr size_t WS_WS = 4 * MiB;
constexpr size_t WS_WGU = 8 * MiB;
constexpr size_t WS_WD = 96 * MiB;
constexpr size_t WS_WIN = 140 * MiB;
constexpr size_t WS_WOUT = 160 * MiB;
constexpr size_t WS_H = 168 * MiB;
constexpr size_t WS_S16 = 276 * MiB;
constexpr size_t WS_Y = 176 * MiB;
constexpr size_t WS_Z = 212 * MiB;
constexpr size_t WS_R1 = 340 * MiB;
constexpr size_t R1_UV = WS_R1;
constexpr size_t R1_QB = R1_UV + (size_t)TT * 512 * 2;
constexpr size_t R1_QC = R1_QB + (size_t)TT * 512 * 2;
constexpr size_t R1_KB = R1_QC + (size_t)TT * 256 * 2;
constexpr size_t R1_VB = R1_KB + (size_t)NB * 4 * NKEY * 128 * 2;
constexpr size_t R1_KC = R1_VB + (size_t)NB * 4 * NKEY * 128 * 2;
constexpr size_t R1_VC = R1_KC + (size_t)NB * 2 * NKEY * 64 * 2;
constexpr size_t R1_O = R1_VC + (size_t)NB * 2 * NKEY * 64 * 2;
constexpr size_t WS_END = R1_O + (size_t)TT * 1024 * 2;
static_assert(WS_Z + (size_t)(T_LAT + 8 * T_CTX) * DM * 4 <= WS_R1 && WS_R1 + (size_t)TT * DFF * 2 <= 476 * MiB && WS_END <= 476 * MiB, "ws map");
constexpr size_t WS_NEED = 476 * MiB;

constexpr int LDS_BYTES = 131072 + 2048;
constexpr int NPHASE = 2 + 10 * DEPTH;

__device__ __forceinline__ unsigned cvt_pk_bf16(float lo, float hi) { unsigned r; asm volatile("v_cvt_pk_bf16_f32 %0, %1, %2" : "=v"(r) : "v"(lo), "v"(hi)); return r; }
__device__ __forceinline__ float wave_sum(float v) {
    v += __uint_as_float(__builtin_amdgcn_update_dpp(0u, __float_as_uint(v), 0xB1, 0xF, 0xF, true));
    v += __uint_as_float(__builtin_amdgcn_update_dpp(0u, __float_as_uint(v), 0x4E, 0xF, 0xF, true));
    v += __uint_as_float(__builtin_amdgcn_update_dpp(0u, __float_as_uint(v), 0x141, 0xF, 0xF, true));
    v += __uint_as_float(__builtin_amdgcn_update_dpp(0u, __float_as_uint(v), 0x140, 0xF, 0xF, true));
    { const unsigned u = __float_as_uint(v); const auto r = __builtin_amdgcn_permlane16_swap(u, u, false, false); v = __uint_as_float(r[0]) + __uint_as_float(r[1]); }
    { const unsigned u = __float_as_uint(v); const auto r = __builtin_amdgcn_permlane32_swap(u, u, false, false); v = __uint_as_float(r[0]) + __uint_as_float(r[1]); }
    return v;
}
__device__ __forceinline__ float fmax2(float a, float b) { return __builtin_amdgcn_fmed3f(a, b, 3.0e38f); }
__device__ __forceinline__ float silu_f(float g) { return g * __builtin_amdgcn_rcpf(1.f + __expf(-g)); }
__device__ __forceinline__ float gelu_tanh_f(float x) { const float y = 1.5957691216057308f * (x + 0.044715f * x * x * x); return x * __builtin_amdgcn_rcpf(1.f + __expf(-y)); }

namespace pg8 {
constexpr int BM = 256, BK = 64, HALF = 128, HTB = HALF * BK * 2, STAGE_BYTES = 8 * HTB, NXCD = 8, WGM = 8;
__host__ __device__ __forceinline__ int lds_byte(int r, int c) { const int st = (r >> 4) * 2 + (c >> 5), rr = r & 15, cc = c & 31, ob = rr * 64 + cc * 2; return st * 1024 + (ob ^ (((ob >> 9) & 1) << 5)); }
__host__ __device__ __forceinline__ void stage_rc(int b, int& R, int& C) { const int st = b / 1024, sb = b % 1024, swz = sb ^ (((sb >> 9) & 1) << 5); R = (st >> 1) * 16 + swz / 64; C = (st & 1) * 32 + (swz % 64) / 2; }
__host__ __device__ __forceinline__ int perm32(int rho) { const int n = rho >> 4, i = rho & 15; return 8 * (i >> 2) + 4 * n + (i & 3); }

struct Unit { int pm, pn, k0, nk, part; };
struct Gemm { const bf16_t* A; const bf16_t* Bt; int M, N, K; };

struct StaticOrder {
    int nM, nN, nwg, G, c, nkt;
    __host__ __device__ void init(int M, int N, int G_, int c_) { nM = M / BM; nN = N / BM; nwg = nM * nN; G = G_; c = c_; nkt = 0; }
    __host__ __device__ bool next(int i, Unit& u) const {
        const long L = (long)i * G + c; if (L >= nwg) return false;
        int wgid = (int)L; { const int q = nwg / NXCD, r = nwg % NXCD, xcd = wgid % NXCD, off = wgid / NXCD; wgid = (xcd < r ? xcd * (q + 1) : r * (q + 1) + (xcd - r) * q) + off; }
        const int nig = WGM * nN, gid = wgid / nig, fm = gid * WGM, gsz = (nM - fm) < WGM ? (nM - fm) : WGM;
        u.pm = fm + ((wgid % nig) % gsz); u.pn = (wgid % nig) / gsz; u.k0 = 0; u.nk = nkt; u.part = -1; return true;
    }
    __device__ __forceinline__ void a_ready(const Unit&) const {}
    __device__ __forceinline__ void done(const Unit&) const {}
};
struct SplitOrder {
    int G, c, nitems, nkt;
    __host__ __device__ void init(int M, int K, int G_, int c_) { G = G_; c = c_; nkt = K / BK; nitems = 256 + (M > T_LAT ? 256 : 0); }
    __host__ __device__ bool next(int i, Unit& u) const {
        const int L = i * G + c; if (L >= nitems) return false;
        const int w = (L & 7) * 32 + ((L >> 3) & 31), lpm = (w >> 5) * 8 + (w & 7), lpn = (w & 31) >> 3;
        const int v = L - 256, cu = v >> 3, part = v & 7;
        const bool ctx = L >= 256;
        const int ck0 = (nkt == 44) ? (part < 6 ? 6 * part : 36 + 4 * (part - 6)) : part * (nkt >> 3);
        const int cnk = (nkt == 44) ? (part < 6 ? 6 : 4) : (nkt >> 3);
        u.pm = ctx ? 64 + (cu >> 2) : lpm; u.pn = ctx ? (cu & 3) : lpn; u.part = ctx ? part : -1; u.k0 = ctx ? ck0 : 0; u.nk = ctx ? cnk : nkt;
        return true;
    }
    __device__ __forceinline__ void a_ready(const Unit&) const {}
    __device__ __forceinline__ void done(const Unit&) const {}
};


struct EpiSwiGLU {
    static constexpr bool PERM = true, AFTER_DRAIN = false;
    bf16_t* O;
    __device__ __forceinline__ void operator()(const f32x4 (&acc)[2][2][4][2], const Unit& u, int wr, int wc, int fr, int fq) const {
        const int row0 = u.pm * BM + wr * 64 + fr, col0 = u.pn * 128 + wc * 32 + 8 * fq;
#pragma unroll
        for (int ai = 0; ai < 2; ++ai)
#pragma unroll
            for (int m = 0; m < 4; ++m) {
                bf16_t* p = O + (size_t)(row0 + ai * HALF + m * 16) * DFF + col0;
                const f32x4 g0 = acc[ai][0][m][0], g1 = acc[ai][0][m][1], u0 = acc[ai][1][m][0], u1 = acc[ai][1][m][1];
                u32x4 w;
#define SGLU(g_, u_) ((g_) * (u_) * __builtin_amdgcn_rcpf(1.f + __builtin_amdgcn_exp2f(-(g_))))
                w.x = cvt_pk_bf16(SGLU(g0[0], u0[0]), SGLU(g0[1], u0[1])); w.y = cvt_pk_bf16(SGLU(g0[2], u0[2]), SGLU(g0[3], u0[3]));
                w.z = cvt_pk_bf16(SGLU(g1[0], u1[0]), SGLU(g1[1], u1[1])); w.w = cvt_pk_bf16(SGLU(g1[2], u1[2]), SGLU(g1[3], u1[3]));
#undef SGLU
                *(u32x4*)p = w;
            }
    }
};
struct EpiZ16 {
    static constexpr bool PERM = true, AFTER_DRAIN = false;
    bf16_t* Z;
    __device__ __forceinline__ void operator()(const f32x4 (&acc)[2][2][4][2], const Unit& u, int wr, int wc, int fr, int fq) const {
        const int row0 = u.pm * BM + wr * 64 + fr + (u.part > 0 ? u.part * T_CTX : 0), col0 = u.pn * BM + wc * 32 + 8 * fq;
#pragma unroll
        for (int ai = 0; ai < 2; ++ai)
#pragma unroll
            for (int m = 0; m < 4; ++m) {
                bf16_t* p = Z + (size_t)(row0 + ai * HALF + m * 16) * DM + col0;
#pragma unroll
                for (int bj = 0; bj < 2; ++bj) { const f32x4 v0 = acc[ai][bj][m][0], v1 = acc[ai][bj][m][1];
                    *(u32x4*)(p + bj * HALF) = (u32x4){cvt_pk_bf16(v0[0], v0[1]), cvt_pk_bf16(v0[2], v0[3]), cvt_pk_bf16(v1[0], v1[1]), cvt_pk_bf16(v1[2], v1[3])}; }
            }
    }
};
struct EpiInProj {
    static constexpr bool PERM = false, AFTER_DRAIN = false;
    bf16_t *UV, *QB, *QC, *KB, *VBt, *KC, *VCt; const f32x2* rope;
    __device__ __forceinline__ void operator()(const f32x4 (&acc)[2][2][4][2], const Unit& u, int wr, int wc, int fr, int fq) const {
        const int pn = u.pn; const bool lat = u.pm < (T_LAT / BM);
#pragma unroll
        for (int ai = 0; ai < 2; ++ai)
#pragma unroll
            for (int m = 0; m < 4; ++m) {
                const int r = u.pm * BM + ai * HALF + wr * 64 + m * 16 + fr;
                int b, s, keyidx;
                if (lat) { b = r >> 11; s = r & 2047; keyidx = CTXL + s; } else { const int rc = r - T_LAT; b = rc >> 8; s = 0; keyidx = rc & 255; }
#pragma unroll
                for (int bj = 0; bj < 2; ++bj) {
                    f32x4 v0 = acc[ai][bj][m][0], v1 = acc[ai][bj][m][1];
                    const bool is_rope = (pn >= 2 && pn <= 6) || (pn == 9 && bj == 0);
                    if (is_rope && lat) {
                        const int pos = (wc & 1) ? (s & 63) : (s >> 6);
                        const f32x4 c01 = *(const f32x4*)(rope + pos * 16 + 4 * fq), c23 = *(const f32x4*)(rope + pos * 16 + 4 * fq + 2);
                        const float cs[4] = {c01[0], c01[2], c23[0], c23[2]}, sn[4] = {c01[1], c01[3], c23[1], c23[3]};
#pragma unroll
                        for (int i = 0; i < 4; ++i) { const float x0 = v0[i], x1 = v1[i]; v0[i] = x0 * cs[i] - x1 * sn[i]; v1[i] = x1 * cs[i] + x0 * sn[i]; }
                    }
                    const int ctb = bj * HALF + wc * 32 + 4 * fq;
                    if (pn <= 1) {
#pragma unroll
                        for (int i = 0; i < 4; ++i) { v0[i] = gelu_tanh_f(v0[i]); v1[i] = gelu_tanh_f(v1[i]); }
                        bf16_t* p = UV + (size_t)r * 512 + pn * 256 + ctb;
                        *(u32x2*)p = (u32x2){cvt_pk_bf16(v0[0], v0[1]), cvt_pk_bf16(v0[2], v0[3])}; *(u32x2*)(p + 16) = (u32x2){cvt_pk_bf16(v1[0], v1[1]), cvt_pk_bf16(v1[2], v1[3])};
                    } else if (pn <= 4) {
                        v0 = v0 * QSCALE; v1 = v1 * QSCALE;
                        bf16_t* p = (pn <= 3) ? QB + (size_t)r * 512 + (pn - 2) * 256 + ctb : QC + (size_t)r * 256 + ctb;
                        *(u32x2*)p = (u32x2){cvt_pk_bf16(v0[0], v0[1]), cvt_pk_bf16(v0[2], v0[3])}; *(u32x2*)(p + 16) = (u32x2){cvt_pk_bf16(v1[0], v1[1]), cvt_pk_bf16(v1[2], v1[3])};
                    } else if (pn <= 6) {
                        const int ck = (pn - 5) * 256 + ctb, head = ck >> 7, cw = ck & 127;
                        bf16_t* p = KB + ((size_t)(b * 4 + head) * NKEY + keyidx) * 128 + cw;
                        *(u32x2*)p = (u32x2){cvt_pk_bf16(v0[0], v0[1]), cvt_pk_bf16(v0[2], v0[3])}; *(u32x2*)(p + 16) = (u32x2){cvt_pk_bf16(v1[0], v1[1]), cvt_pk_bf16(v1[2], v1[3])};
                    } else if (pn <= 8) {
                        const int cv = (pn - 7) * 256 + ctb, head = cv >> 7, e = cv & 127;
                        bf16_t* p = VBt + ((size_t)(b * 4 + head) * NKEY + keyidx) * 128 + e;
                        *(u32x2*)p = (u32x2){cvt_pk_bf16(v0[0], v0[1]), cvt_pk_bf16(v0[2], v0[3])}; *(u32x2*)(p + 16) = (u32x2){cvt_pk_bf16(v1[0], v1[1]), cvt_pk_bf16(v1[2], v1[3])};
                    } else {
                        const int kv = wc >> 1, d = (wc & 1) * 32 + 4 * fq;
                        if (bj == 0) {
                            bf16_t* p = KC + ((size_t)(b * 2 + kv) * NKEY + keyidx) * 64 + d;
                            *(u32x2*)p = (u32x2){cvt_pk_bf16(v0[0], v0[1]), cvt_pk_bf16(v0[2], v0[3])}; *(u32x2*)(p + 16) = (u32x2){cvt_pk_bf16(v1[0], v1[1]), cvt_pk_bf16(v1[2], v1[3])};
                        } else {
                            bf16_t* p = VCt + ((size_t)(b * 2 + kv) * NKEY + keyidx) * 64 + d;
                            *(u32x2*)p = (u32x2){cvt_pk_bf16(v0[0], v0[1]), cvt_pk_bf16(v0[2], v0[3])}; *(u32x2*)(p + 16) = (u32x2){cvt_pk_bf16(v1[0], v1[1]), cvt_pk_bf16(v1[2], v1[3])};
                        }
                    }
                }
                asm volatile("" ::: "memory");
            }
    }
};

template <class Epi, class Sched, bool ALIGN_EPI = false, bool SP2 = false>
__device__ __forceinline__ void gemm_phase(LAS unsigned char* lds, const Gemm g, const Sched& S, const Epi& E, const int tid) {
    const int wid = __builtin_amdgcn_readfirstlane(tid >> 6), lane = tid & 63, wr = wid >> 2, wc = wid & 3, fr = lane & 15, fq = lane >> 4;
    const int K = g.K;
    unsigned voffA[2], voffB[2];
#pragma unroll
    for (int i = 0; i < 2; ++i) { int R, C; stage_rc(tid * 16 + i * 8192, R, C); const int Rb = Epi::PERM ? ((R & ~31) + perm32(R & 31)) : R;
        voffA[i] = (unsigned)(R * K + C) * 2u; voffB[i] = (unsigned)(Rb * K + C) * 2u; }
    const size_t kstep = (size_t)(BK * 2);
    const size_t hstep = (size_t)HALF * K * 2;
    const size_t tstep = 2 * hstep;
    const unsigned ldsw = (unsigned)wid * 1024u;
    const int aoff = lds_byte(wr * 64 + fr, fq * 8), boff = lds_byte(wc * 32 + fr, fq * 8);
#define PG8_SA(b, h) (((b) * 2 + (h)) * HTB)
#define PG8_SB(b, h) ((4 + (b) * 2 + (h)) * HTB)
#define PG8_STAGE(bufoff, gbase, voff) do { _Pragma("unroll") for (int _i = 0; _i < 2; ++_i) \
        __builtin_amdgcn_global_load_lds((const unsigned*)((const char*)(gbase) + (voff)[_i]), (LAS unsigned*)(lds + (bufoff) + ldsw + _i * 8192), 16, 0, 0); } while (0)
#define PG8_LDA(dst, b, h) do { _Pragma("unroll") for (int m = 0; m < 4; ++m) _Pragma("unroll") for (int k = 0; k < 2; ++k) dst[m][k] = *(const LAS bf16x8*)(lds + PG8_SA(b, h) + aoff + m * 2048 + k * 1024); } while (0)
#define PG8_LDB(dst, b, h) do { _Pragma("unroll") for (int n = 0; n < 2; ++n) _Pragma("unroll") for (int k = 0; k < 2; ++k) dst[n][k] = *(const LAS bf16x8*)(lds + PG8_SB(b, h) + boff + n * 2048 + k * 1024); } while (0)
#define PG8_MMA(ai, bj, At, Bt) do { __builtin_amdgcn_s_setprio(1); _Pragma("unroll") for (int m = 0; m < 4; ++m) _Pragma("unroll") for (int n = 0; n < 2; ++n) _Pragma("unroll") for (int k = 0; k < 2; ++k) \
        acc[ai][bj][m][n] = __builtin_amdgcn_mfma_f32_16x16x32_bf16(Bt[n][k], At[m][k], acc[ai][bj][m][n], 0, 0, 0); __builtin_amdgcn_s_setprio(0); } while (0)
#define PG8_WAIT_V(n) asm volatile("s_waitcnt vmcnt(" #n ")" ::: "memory")
#define PG8_WAIT_L(n) asm volatile("s_waitcnt lgkmcnt(" #n ")" ::: "memory")
#define PG8_BAR __builtin_amdgcn_s_barrier()
#define PG8_SCHED __builtin_amdgcn_sched_barrier(0)
    Unit cur, nxt; int ui = 0;
    if (!S.next(0, cur)) return;
    f32x4 acc[2][2][4][2];
#pragma unroll
    for (int a = 0; a < 2; ++a)
#pragma unroll
        for (int b = 0; b < 2; ++b)
#pragma unroll
            for (int m = 0; m < 4; ++m)
#pragma unroll
                for (int n = 0; n < 2; ++n) acc[a][b][m][n] = (f32x4){0.f, 0.f, 0.f, 0.f};
    bf16x8 At[4][2], B0[2][2], B1[2][2];
    const char* cA = (const char*)g.A + (size_t)cur.pm * tstep + (size_t)cur.k0 * kstep; const char* cB = (const char*)g.Bt + (size_t)cur.pn * tstep + (size_t)cur.k0 * kstep;
    S.a_ready(cur);
    if constexpr (SP2) {
        PG8_STAGE(PG8_SB(0, 0), cB, voffB); PG8_STAGE(PG8_SB(0, 1), cB + hstep, voffB); PG8_STAGE(PG8_SA(0, 0), cA, voffA); PG8_STAGE(PG8_SA(0, 1), cA + hstep, voffA);
        if (wr == 1) PG8_BAR;
        PG8_WAIT_V(2); PG8_BAR;
        PG8_STAGE(PG8_SB(1, 0), cB + kstep, voffB); PG8_STAGE(PG8_SA(1, 0), cA + kstep, voffA); PG8_STAGE(PG8_SB(1, 1), cB + hstep + kstep, voffB);
        PG8_WAIT_V(6); PG8_BAR;
    } else {
        PG8_STAGE(PG8_SB(0, 0), cB, voffB); PG8_STAGE(PG8_SA(0, 0), cA, voffA); PG8_STAGE(PG8_SB(0, 1), cB + hstep, voffB); PG8_STAGE(PG8_SA(0, 1), cA + hstep, voffA);
        if (wr == 1) PG8_BAR;
        PG8_WAIT_V(4); PG8_BAR;
        PG8_STAGE(PG8_SB(1, 0), cB + kstep, voffB); PG8_STAGE(PG8_SA(1, 0), cA + kstep, voffA); PG8_STAGE(PG8_SB(1, 1), cB + hstep + kstep, voffB);
        PG8_WAIT_V(6); PG8_BAR;
    }
    for (;;) {
        const bool has_next = S.next(ui + 1, nxt);
        const char* nA = has_next ? (const char*)g.A + (size_t)nxt.pm * tstep + (size_t)nxt.k0 * kstep : cA; const char* nB = has_next ? (const char*)g.Bt + (size_t)nxt.pn * tstep + (size_t)nxt.k0 * kstep : cB;
        const int nt = cur.nk;
        for (int t = 0; t < nt; t += 2) {
            const bool last = (t == nt - 2);
            const char* a1 = cA + (size_t)(t + 1) * kstep;
            const char* a2 = last ? nA : cA + (size_t)(t + 2) * kstep; const char* b2 = last ? nB : cB + (size_t)(t + 2) * kstep;
            const char* a3 = a2 + kstep; const char* b3 = b2 + kstep;
            if (last && has_next) S.a_ready(nxt);
            if constexpr (SP2) {
            PG8_LDB(B0, 0, 0); PG8_LDB(B1, 0, 1); PG8_SCHED; PG8_LDA(At, 0, 0); PG8_STAGE(PG8_SA(1, 1), a1 + hstep, voffA);
            PG8_WAIT_V(8); PG8_WAIT_L(0); PG8_BAR; PG8_MMA(0, 0, At, B0); PG8_MMA(0, 1, At, B1); PG8_BAR; PG8_SCHED;
            PG8_LDA(At, 0, 1); PG8_STAGE(PG8_SB(0, 0), b2, voffB); PG8_STAGE(PG8_SB(0, 1), b2 + hstep, voffB); PG8_STAGE(PG8_SA(0, 0), a2, voffA);
            PG8_WAIT_V(8); PG8_WAIT_L(0); PG8_BAR; PG8_MMA(1, 0, At, B0); PG8_MMA(1, 1, At, B1); PG8_BAR; PG8_SCHED;
            PG8_LDB(B0, 1, 0); PG8_LDB(B1, 1, 1); PG8_SCHED; PG8_LDA(At, 1, 0); PG8_STAGE(PG8_SA(0, 1), a2 + hstep, voffA);
            PG8_WAIT_V(8); PG8_WAIT_L(0); PG8_BAR; PG8_MMA(0, 0, At, B0); PG8_MMA(0, 1, At, B1); PG8_BAR; PG8_SCHED;
            PG8_LDA(At, 1, 1); PG8_STAGE(PG8_SB(1, 0), b3, voffB); PG8_STAGE(PG8_SB(1, 1), b3 + hstep, voffB); PG8_STAGE(PG8_SA(1, 0), a3, voffA);
            PG8_WAIT_V(8); PG8_WAIT_L(0); PG8_BAR; PG8_MMA(1, 0, At, B0); PG8_MMA(1, 1, At, B1); PG8_BAR; PG8_SCHED;
            } else {
            PG8_LDB(B0, 0, 0); PG8_SCHED; PG8_LDA(At, 0, 0); PG8_STAGE(PG8_SA(1, 1), a1 + hstep, voffA);
            PG8_WAIT_L(8); PG8_BAR; PG8_WAIT_L(0); PG8_MMA(0, 0, At, B0); PG8_BAR; PG8_SCHED;
            PG8_LDB(B1, 0, 1); PG8_STAGE(PG8_SB(0, 0), b2, voffB);
            PG8_BAR; PG8_WAIT_L(0); PG8_MMA(0, 1, At, B1); PG8_BAR;
            PG8_LDA(At, 0, 1); PG8_STAGE(PG8_SA(0, 0), a2, voffA);
            PG8_BAR; PG8_WAIT_L(0); PG8_MMA(1, 0, At, B0); PG8_BAR; PG8_SCHED;
            PG8_STAGE(PG8_SB(0, 1), b2 + hstep, voffB);
            PG8_WAIT_V(6); PG8_BAR; PG8_MMA(1, 1, At, B1); PG8_BAR;
            PG8_LDB(B0, 1, 0); PG8_SCHED; PG8_LDA(At, 1, 0); PG8_STAGE(PG8_SA(0, 1), a2 + hstep, voffA);
            PG8_WAIT_L(8); PG8_BAR; PG8_WAIT_L(0); PG8_MMA(0, 0, At, B0); PG8_BAR; PG8_SCHED;
            PG8_LDB(B1, 1, 1); PG8_STAGE(PG8_SB(1, 0), b3, voffB);
            PG8_BAR; PG8_WAIT_L(0); PG8_MMA(0, 1, At, B1); PG8_BAR;
            PG8_LDA(At, 1, 1); PG8_STAGE(PG8_SA(1, 0), a3, voffA);
            PG8_BAR; PG8_WAIT_L(0); PG8_MMA(1, 0, At, B0); PG8_BAR; PG8_SCHED;
            PG8_STAGE(PG8_SB(1, 1), b3 + hstep, voffB);
            PG8_WAIT_V(6); PG8_BAR; PG8_MMA(1, 1, At, B1); PG8_BAR;
            }
        }
        if constexpr (ALIGN_EPI) { if (wr == 0) PG8_BAR; }
        if constexpr (!Epi::AFTER_DRAIN) { E(acc, cur, wr, wc, fr, fq); S.done(cur); }
        if (!has_next) break;
#pragma unroll
        for (int a = 0; a < 2; ++a)
#pragma unroll
            for (int b = 0; b < 2; ++b)
#pragma unroll
                for (int m = 0; m < 4; ++m)
#pragma unroll
                    for (int n = 0; n < 2; ++n) acc[a][b][m][n] = (f32x4){0.f, 0.f, 0.f, 0.f};
        cur = nxt; cA = nA; cB = nB; ++ui;
        if constexpr (ALIGN_EPI) { if (wr == 1) PG8_BAR; }
    }
    PG8_WAIT_V(0);
    if constexpr (!ALIGN_EPI) { if (wr == 0) PG8_BAR; }
    PG8_BAR;
#undef PG8_SA
#undef PG8_SB
#undef PG8_STAGE
#undef PG8_LDA
#undef PG8_LDB
#undef PG8_MMA
#undef PG8_WAIT_V
#undef PG8_WAIT_L
#undef PG8_BAR
#undef PG8_SCHED
}
}


#define XB_TMO      128
#define XB_XCNT(j)  (256  + 64 * (j))
#define XB_XSUB(j)  (1280 + 64 * (j))
#define XB_XGEN(j)  (2304 + 64 * (j))
#define XB_TOP      3328
#define XB_TOPGEN   3392
#define XCD_BAR_WORDS 3456
#define XB_SPIN_CAP (1u << 18)
__device__ __forceinline__ unsigned xb_ld(unsigned* p)              { return __hip_atomic_load(p, __ATOMIC_RELAXED, __HIP_MEMORY_SCOPE_AGENT); }
__device__ __forceinline__ unsigned xb_add(unsigned* p, unsigned v) { return __hip_atomic_fetch_add(p, v, __ATOMIC_RELAXED, __HIP_MEMORY_SCOPE_AGENT); }
__device__ __forceinline__ unsigned xb_xcc_id() { return (unsigned)__builtin_amdgcn_s_getreg((3 << 11) | 20) & 0xFu; }
#define XB_SPIN(cond, bar) do { unsigned _sp = 0; while (cond) { __builtin_amdgcn_s_sleep(1); \
    if ((++_sp & 255u) == 0u) { if (xb_ld(&(bar)[XB_TMO])) break; if (_sp > XB_SPIN_CAP) { atomicAdd(&(bar)[XB_TMO], 1u); break; } } } } while (0)
struct XcdBarrier { unsigned* bar; unsigned x; volatile LAS unsigned* st; };
__device__ __forceinline__ XcdBarrier xcd_barrier_post(unsigned* bar, volatile LAS unsigned* st) {
    XcdBarrier b; b.bar = bar; b.x = xb_xcc_id(); b.st = st;
    if (threadIdx.x == 0) (void)xb_add(&bar[XB_XCNT(b.x)], 1u);
    return b;
}
__device__ __forceinline__ void xcd_barrier_complete(unsigned* bar, unsigned x, unsigned& nloc, unsigned& nx) {
    const unsigned G = gridDim.x * gridDim.y * gridDim.z;
    unsigned sum, cnt, mine, sp = 0u;
    for (;;) {
        sum = 0u; cnt = 0u; mine = 0u;
#pragma unroll
        for (unsigned j = 0; j < 16; ++j) { const unsigned c = xb_ld(&bar[XB_XCNT(j)]); sum += c; cnt += (c > 0u) ? 1u : 0u; mine = (j == x) ? c : mine; }
        if (sum == G) break;
        __builtin_amdgcn_s_sleep(1);
        if ((++sp & 255u) == 0u) { if (xb_ld(&bar[XB_TMO])) break; if (sp > XB_SPIN_CAP) { atomicAdd(&bar[XB_TMO], 1u); break; } }
    }
    nloc = mine > 0u ? mine : 1u; nx = cnt > 0u ? cnt : 1u;
}
__device__ __forceinline__ void xcd_barrier(const XcdBarrier& b) {
    asm volatile("s_waitcnt vmcnt(0)" ::: "memory");
    __syncthreads();
    if (threadIdx.x == 0) {
        unsigned* bar = b.bar;
        __builtin_amdgcn_s_waitcnt(0);
        unsigned nloc = b.st[0], nx = b.st[1];
        if (nloc == 0u) { xcd_barrier_complete(bar, b.x, nloc, nx); b.st[0] = nloc; b.st[1] = nx; }
        const unsigned old = xb_add(&bar[XB_XSUB(b.x)], 1u);
        const unsigned gen = old / nloc;
        if (old + 1u == (gen + 1u) * nloc) {
            __builtin_amdgcn_fence(__ATOMIC_RELEASE, "agent");
            asm volatile("s_waitcnt vmcnt(0)" ::: "memory");
            const unsigned og = xb_add(&bar[XB_TOP], 1u);
            const unsigned tg = og / nx;
            if (og + 1u == (tg + 1u) * nx) xb_add(&bar[XB_TOPGEN], 1u);
            else XB_SPIN(xb_ld(&bar[XB_TOPGEN]) == tg, bar);
            __builtin_amdgcn_fence(__ATOMIC_ACQUIRE, "agent");
            xb_add(&bar[XB_XGEN(b.x)], 1u);
            asm volatile("s_waitcnt vmcnt(0)" ::: "memory");
        } else {
            XB_SPIN(xb_ld(&bar[XB_XGEN(b.x)]) == gen, bar);
            __builtin_amdgcn_fence(__ATOMIC_ACQUIRE, "agent");
            asm volatile("s_waitcnt vmcnt(0)" ::: "memory");
        }
    }
    __syncthreads();
}

struct Args { const float* in[19]; float* out; unsigned char* ws; int ph_lo, ph_hi; };
enum { I_X = 0, I_C, I_CTX, I_CCTX, I_WMOD, I_BMOD, I_NPRE, I_NPOST, I_WG, I_WU, I_WD, I_WIN, I_WOUT, I_VGAIN, I_WS, I_BS, I_LAM, I_SUBLN, I_SINK };

#define LDS_WAIT() asm volatile("s_waitcnt lgkmcnt(0)" ::: "memory")

__device__ __forceinline__ void transpose_item(const float* __restrict__ W, int N, int k0, int n0, bf16_t* __restrict__ WT, int K, int drow0, LAS float* scr, int lane, float wscale = 1.0f) {
#pragma unroll 8
    for (int i = 0; i < 32; ++i) { const int kk = 2 * i + (lane >> 5); scr[kk * 33 + (lane & 31)] = __builtin_nontemporal_load(W + (size_t)(k0 + kk) * N + n0 + (lane & 31)); }
    LDS_WAIT(); asm volatile("" ::: "memory");
    const int c = lane & 7;
#pragma unroll
    for (int j = 0; j < 4; ++j) { const int n = (lane >> 3) + 8 * j; const LAS float* s = scr + (8 * c) * 33 + n;
        u32x4 o; o.x = cvt_pk_bf16(s[0 * 33] * wscale, s[1 * 33] * wscale); o.y = cvt_pk_bf16(s[2 * 33] * wscale, s[3 * 33] * wscale); o.z = cvt_pk_bf16(s[4 * 33] * wscale, s[5 * 33] * wscale); o.w = cvt_pk_bf16(s[6 * 33] * wscale, s[7 * 33] * wscale);
        __builtin_nontemporal_store(o, (u32x4*)(WT + (size_t)(drow0 + n0 + n) * K + k0 + 8 * c)); }
    LDS_WAIT(); asm volatile("" ::: "memory");
}

__device__ __forceinline__ void prologue_a(const Args& a, LAS unsigned char* lds, int tid, int G) {
    const int lane = tid & 63, wave = tid >> 6;
    unsigned char* ws = a.ws;
    {
        LAS float* scr = (LAS float*)(lds + wave * 16384);
        const int gw = blockIdx.x * 8 + wave, NGW = G * 8;
        constexpr int PER_L = 10240;
        for (int it = gw; it < DEPTH * PER_L; it += NGW) {
            const int l = it / PER_L; int r = it % PER_L;
            if (r < 5632) {
                const int up = r >= 2816; if (up) r -= 2816;
                const int sub = r / 1408, rr = r % 1408, kb = rr / 88, nb = rr % 88, n0 = nb * 32;
                const float* W = a.in[up ? I_WU : I_WG] + (size_t)(l * 2 + sub) * DM * DFF;
                bf16_t* WT = (bf16_t*)(ws + WS_WGU) + (size_t)(l * 2 + sub) * NGU * DM;
                transpose_item(W, DFF, kb * 64, n0, WT, DM, 256 * (n0 >> 7) + (up ? 128 : 0) + (n0 & 127) - n0, scr, lane, up ? (1.0f / LOG2E) : LOG2E);
            } else if (r < 8448) {
                r -= 5632; const int sub = r / 1408, rr = r % 1408, kb = rr / 32, nb = rr % 32;
                const float* W = a.in[I_WD] + (size_t)(l * 2 + sub) * DFF * DM;
                bf16_t* WT = (bf16_t*)(ws + WS_WD) + (size_t)(l * 2 + sub) * DM * DFF;
                transpose_item(W, DM, kb * 64, nb * 32, WT, DFF, 0, scr, lane);
            } else if (r < 9728) {
                r -= 8448; const int kb = r / 80, nb = r % 80;
                transpose_item(a.in[I_WIN] + (size_t)l * DM * INC, INC, kb * 64, nb * 32, (bf16_t*)(ws + WS_WIN) + (size_t)l * INC * DM, DM, 0, scr, lane);
            } else {
                r -= 9728; const int kb = r / 32, nb = r % 32;
                transpose_item(a.in[I_WOUT] + (size_t)l * DM * DM, DM, kb * 64, nb * 32, (bf16_t*)(ws + WS_WOUT) + (size_t)l * DM * DM, DM, 0, scr, lane);
            }
        }
        const float* wsrc = a.in[I_WS]; bf16_t* wdst = (bf16_t*)(ws + WS_WS);
        for (int i = (blockIdx.x * 512 + tid); i < DEPTH * 4 * 128 * 128 / 8; i += G * 512) {
            const f32x4 v0 = *(const f32x4*)(wsrc + (size_t)i * 8), v1 = *(const f32x4*)(wsrc + (size_t)i * 8 + 4);
            *(u32x4*)(wdst + (size_t)i * 8) = (u32x4){cvt_pk_bf16(v0[0], v0[1]), cvt_pk_bf16(v0[2], v0[3]), cvt_pk_bf16(v1[0], v1[1]), cvt_pk_bf16(v1[2], v1[3])};
        }
    }
    __syncthreads();
    {
        LAS float* sc = (LAS float*)lds;
        LAS float* red = (LAS float*)(lds + 9 * 1024 * 4);
        for (int i = tid; i < 9 * 1024; i += 512) { const int m = i >> 10, k = i & 1023; const float v = (m < 8) ? a.in[I_C][m * 1024 + k] : a.in[I_CCTX][k]; sc[i] = silu_f(v); }
        __syncthreads();
        float* MOD = (float*)(ws + WS_MOD);
        const int kq = tid >> 7, jj = tid & 127;
        for (int it = blockIdx.x; it < DEPTH * 72; it += G) {
            const int l = it / 72, cb = it % 72, col = cb * 128 + jj;
            const float* wp = a.in[I_WMOD] + (size_t)l * DM * 9216 + col;
            float acc[9];
#pragma unroll
            for (int m = 0; m < 9; ++m) acc[m] = 0.f;
#pragma unroll 4
            for (int k = kq * 256; k < kq * 256 + 256; ++k) {
                const float w = __builtin_nontemporal_load(wp + (size_t)k * 9216);
#pragma unroll
                for (int m = 0; m < 9; ++m) acc[m] += sc[m * 1024 + k] * w;
            }
#pragma unroll
            for (int m = 0; m < 9; ++m) red[(kq * 9 + m) * 128 + jj] = acc[m];
            __syncthreads();
            for (int o = tid; o < 9 * 128; o += 512) { const int m = o >> 7, j2 = o & 127;
                const float v = red[(0 * 9 + m) * 128 + j2] + red[(1 * 9 + m) * 128 + j2] + red[(2 * 9 + m) * 128 + j2] + red[(3 * 9 + m) * 128 + j2];
                MOD[((size_t)l * 9 + m) * 9216 + cb * 128 + j2] = v + a.in[I_BMOD][l * 9216 + cb * 128 + j2]; }
            __syncthreads();
        }
    }
    if (blockIdx.x == 0) {
        f32x2* rope = (f32x2*)(ws + WS_ROPE);
        for (int i = tid; i < 64 * 16; i += 512) { const int pos = i >> 4, j = i & 15; const float inv = powf(10000.0f, -(float)j / 16.0f); const float ang = (float)pos * inv; rope[i] = (f32x2){cosf(ang), sinf(ang)}; }
    }
    if (blockIdx.x == (G > 1 ? 1 : 0) && wave == 0) {
        float* LAM = (float*)(ws + WS_LAM);
        for (int l = 0; l < DEPTH; ++l) {
            const float* lp = a.in[I_LAM] + l * 256;
            const float s1 = wave_sum(lp[lane] * lp[64 + lane]), s2 = wave_sum(lp[128 + lane] * lp[192 + lane]);
            const float lam_init = 0.8f - 0.6f * expf(-0.3f * (float)l);
            if (lane == 0) { LAM[l] = expf(s1) - expf(s2) + lam_init; LAM[4 + l] = 1.0f - lam_init; }
        }
    }
}

__device__ __forceinline__ void unpack8(const u32x4 w, f32x4& lo, f32x4& hi) {
    lo = (f32x4){__uint_as_float(w.x << 16), __uint_as_float(w.x & 0xffff0000u), __uint_as_float(w.y << 16), __uint_as_float(w.y & 0xffff0000u)};
    hi = (f32x4){__uint_as_float(w.z << 16), __uint_as_float(w.z & 0xffff0000u), __uint_as_float(w.w << 16), __uint_as_float(w.w & 0xffff0000u)};
}
__device__ __forceinline__ void norm_phase(const Args& a, LAS unsigned char* lds, int l, int j, int l2, int j2, int nrows, float wgt, int tid, int G) {
    const int lane = tid & 63, wave = tid >> 6;
    unsigned char* ws = a.ws;
    const float* MOD = (const float*)(ws + WS_MOD);
    const bf16_t* Z = (const bf16_t*)(ws + WS_Z);
    bf16_t* S16 = (bf16_t*)(ws + WS_S16);
    bf16_t* Y = (bf16_t*)(ws + WS_Y);
    const int NW = G * 8, gw = blockIdx.x * 8 + wave;
    const int lc = (T_LAT + NW - 1) / NW, cc = (nrows > T_LAT) ? (nrows - T_LAT + NW - 1) / NW : 0;
    const int la = gw * lc < T_LAT ? gw * lc : T_LAT, lb = (la + lc < T_LAT) ? la + lc : T_LAT;
    const int ca0 = T_LAT + gw * cc, ca = ca0 < nrows ? ca0 : nrows, cb = (ca + cc < nrows) ? ca + cc : nrows;
    const int nmine = (lb - la) + (cb - ca);
#define NORM_ROW(i_) ((i_) < lb - la ? la + (i_) : ca + ((i_) - (lb - la)))
    const int cl = 8 * lane;
    const int mfirst = ((int)blockIdx.x * 8 * lc) >> 11, mlastr = ((int)blockIdx.x * 8 + 7) * lc + lc - 1, mlast = (mlastr < T_LAT ? mlastr : T_LAT - 1) >> 11;
    const bool use_lds = (mfirst == mlast) && ((int)blockIdx.x * 8 * lc < T_LAT);
    LAS f32x4* vlds = (LAS f32x4*)lds;
    if (use_lds) {
        const int set = tid >> 8, c4 = tid & 255, mm = set ? 8 : mfirst, c = 4 * c4;
        float z0_ = 0.f; asm volatile("" : "+v"(z0_));
        f32x4 av = (f32x4){z0_, z0_, z0_, z0_}, bv = av, cv = av;
        if (l >= 0) av = *(const f32x4*)(MOD + ((size_t)l * 9 + mm) * 9216 + (3 * j + 2) * DM + c) * *(const f32x4*)(a.in[I_NPOST] + (size_t)(l * 3 + j) * DM + c) * wgt;
        if (l2 < DEPTH) { const float* shift = MOD + ((size_t)l2 * 9 + mm) * 9216 + (3 * j2) * DM;
            bv = *(const f32x4*)(a.in[I_NPRE] + (size_t)(l2 * 3 + j2) * DM + c) * (*(const f32x4*)(shift + DM + c) + 1.0f); cv = *(const f32x4*)(shift + c); }
        vlds[(set * 3 + 0) * 256 + c4] = av; vlds[(set * 3 + 1) * 256 + c4] = bv; vlds[(set * 3 + 2) * 256 + c4] = cv;
    }
    __syncthreads();
    const bool final_out = (l2 >= DEPTH);
    int mcur = -1;
    f32x4 Av[4], Bv[4], Cv[4];
#pragma unroll
    for (int k = 0; k < 4; ++k) { Av[k] = (f32x4){0.f, 0.f, 0.f, 0.f}; Bv[k] = Av[k]; Cv[k] = Av[k]; }
    u32x4 zc0 = (u32x4){0u, 0u, 0u, 0u}, zc1 = zc0, qc0 = zc0, qc1 = zc0; f32x4 xc[4];
#pragma unroll
    for (int k = 0; k < 4; ++k) xc[k] = (f32x4){0.f, 0.f, 0.f, 0.f};
#define NORM_LOAD(row_, z0_, z1_, q0_, q1_, x_) do { \
        if (l < 0) { const float* src_ = ((row_) < T_LAT) ? a.in[I_X] + (size_t)(row_) * DM : a.in[I_CTX] + (size_t)((row_) - T_LAT) * DM; \
            _Pragma("unroll") for (int k = 0; k < 4; ++k) x_[k] = __builtin_nontemporal_load((const f32x4*)(src_ + 512 * (k >> 1) + cl + 4 * (k & 1))); } \
        else { z0_ = __builtin_nontemporal_load((const u32x4*)(Z + (size_t)(row_) * DM + cl)); z1_ = __builtin_nontemporal_load((const u32x4*)(Z + (size_t)(row_) * DM + 512 + cl)); \
            q0_ = __builtin_nontemporal_load((const u32x4*)(S16 + (size_t)(row_) * DM + cl)); q1_ = __builtin_nontemporal_load((const u32x4*)(S16 + (size_t)(row_) * DM + 512 + cl)); } } while (0)
    if (nmine > 0) NORM_LOAD(NORM_ROW(0), zc0, zc1, qc0, qc1, xc);
    for (int ri = 0; ri < nmine; ++ri) {
        const int row = NORM_ROW(ri);
        const bool lat = row < T_LAT;
        const int m = lat ? (row >> 11) : 8;
        u32x4 zn0 = zc0, zn1 = zc1, qn0 = qc0, qn1 = qc1; f32x4 xn[4];
#pragma unroll
        for (int k = 0; k < 4; ++k) xn[k] = xc[k];
        if (ri + 1 < nmine) { const int rown = NORM_ROW(ri + 1); NORM_LOAD(rown, zn0, zn1, qn0, qn1, xn); }
        if (m != mcur && use_lds) {
            mcur = m;
            const int set = (m == 8) ? 1 : 0;
#pragma unroll
            for (int k = 0; k < 4; ++k) { const int c4 = (512 * (k >> 1) + cl + 4 * (k & 1)) >> 2; Av[k] = vlds[(set * 3 + 0) * 256 + c4]; Bv[k] = vlds[(set * 3 + 1) * 256 + c4]; Cv[k] = vlds[(set * 3 + 2) * 256 + c4]; }
        }
        if (m != mcur) {
            mcur = m;
            if (l >= 0) {
                const float* gate = MOD + ((size_t)l * 9 + m) * 9216 + (3 * j + 2) * DM;
                const float* post = a.in[I_NPOST] + (size_t)(l * 3 + j) * DM;
#pragma unroll
                for (int k = 0; k < 4; ++k) { const int c = 512 * (k >> 1) + cl + 4 * (k & 1); Av[k] = *(const f32x4*)(gate + c) * *(const f32x4*)(post + c) * wgt; }
            }
            if (l2 < DEPTH) {
                const float* shift = MOD + ((size_t)l2 * 9 + m) * 9216 + (3 * j2) * DM;
                const float* scale = shift + DM;
                const float* pre = a.in[I_NPRE] + (size_t)(l2 * 3 + j2) * DM;
#pragma unroll
                for (int k = 0; k < 4; ++k) { const int c = 512 * (k >> 1) + cl + 4 * (k & 1); Bv[k] = *(const f32x4*)(pre + c) * (*(const f32x4*)(scale + c) + 1.0f); Cv[k] = *(const f32x4*)(shift + c); }
            }
        }
        f32x4 sv[4];
        if (l < 0) {
#pragma unroll
            for (int k = 0; k < 4; ++k) sv[k] = xc[k];
        } else {
            unpack8(qc0, sv[0], sv[1]); unpack8(qc1, sv[2], sv[3]);
            f32x4 zv[4];
            unpack8(zc0, zv[0], zv[1]); unpack8(zc1, zv[2], zv[3]);
            if (!lat) {
#pragma unroll
                for (int pp = 1; pp < 8; ++pp) { const bf16_t* zp = Z + (size_t)(row + pp * T_CTX) * DM + cl; f32x4 t0, t1, t2, t3;
                    unpack8(*(const u32x4*)zp, t0, t1); unpack8(*(const u32x4*)(zp + 512), t2, t3); zv[0] += t0; zv[1] += t1; zv[2] += t2; zv[3] += t3; }
            }
            float ss = 0.f;
#pragma unroll
            for (int k = 0; k < 4; ++k) ss += (zv[k][0] * zv[k][0] + zv[k][1] * zv[k][1]) + (zv[k][2] * zv[k][2] + zv[k][3] * zv[k][3]);
            ss = wave_sum(ss);
            const float rstd = rsqrtf(ss * (1.0f / DM) + EPSV);
#pragma unroll
            for (int k = 0; k < 4; ++k) sv[k] += Av[k] * (zv[k] * rstd);
        }
        if (final_out) {
            float* orow = a.out + (size_t)row * DM;
#pragma unroll
            for (int k = 0; k < 4; ++k) *(f32x4*)(orow + 512 * (k >> 1) + cl + 4 * (k & 1)) = sv[k];
        } else {
            __builtin_nontemporal_store((u32x4){cvt_pk_bf16(sv[0][0], sv[0][1]), cvt_pk_bf16(sv[0][2], sv[0][3]), cvt_pk_bf16(sv[1][0], sv[1][1]), cvt_pk_bf16(sv[1][2], sv[1][3])}, (u32x4*)(S16 + (size_t)row * DM + cl));
            __builtin_nontemporal_store((u32x4){cvt_pk_bf16(sv[2][0], sv[2][1]), cvt_pk_bf16(sv[2][2], sv[2][3]), cvt_pk_bf16(sv[3][0], sv[3][1]), cvt_pk_bf16(sv[3][2], sv[3][3])}, (u32x4*)(S16 + (size_t)row * DM + 512 + cl));
        }
        if (l2 < DEPTH) {
            float ss = 0.f;
#pragma unroll
            for (int k = 0; k < 4; ++k) ss += (sv[k][0] * sv[k][0] + sv[k][1] * sv[k][1]) + (sv[k][2] * sv[k][2] + sv[k][3] * sv[k][3]);
            ss = wave_sum(ss);
            const float rstd = rsqrtf(ss * (1.0f / DM) + EPSV);
            f32x4 y[4];
#pragma unroll
            for (int k = 0; k < 4; ++k) y[k] = (sv[k] * rstd) * Bv[k] + Cv[k];
            *(u32x4*)(Y + (size_t)row * DM + cl) = (u32x4){cvt_pk_bf16(y[0][0], y[0][1]), cvt_pk_bf16(y[0][2], y[0][3]), cvt_pk_bf16(y[1][0], y[1][1]), cvt_pk_bf16(y[1][2], y[1][3])};
            *(u32x4*)(Y + (size_t)row * DM + 512 + cl) = (u32x4){cvt_pk_bf16(y[2][0], y[2][1]), cvt_pk_bf16(y[2][2], y[2][3]), cvt_pk_bf16(y[3][0], y[3][1]), cvt_pk_bf16(y[3][2], y[3][3])};
        }
        zc0 = zn0; zc1 = zn1; qc0 = qn0; qc1 = qn1;
#pragma unroll
        for (int k = 0; k < 4; ++k) xc[k] = xn[k];
    }
#undef NORM_LOAD
#undef NORM_ROW
}

template <int NMAP, int VD, bool SWA>
__device__ __forceinline__ void attn_unit(LAS unsigned char* lds, const bf16_t* __restrict__ Qp, int qpitch, const bf16_t* __restrict__ Kb, const bf16_t* __restrict__ Vt,
                                          int n0, int t1lo, int t1hi, int qp0, float sink_l2, float lam, const float* __restrict__ gsub, float post_scale, bf16_t* __restrict__ Op, int tid) {
    constexpr int KW = SWA ? 64 : 64 * NMAP, KMS = SWA ? 0 : 64, KP = 144, VP = 144, NKC = KW / 64, NVC = VD / 64, NET = VD / 16;
    constexpr int KBYTES = 64 * KP * 2, BUFB = KBYTES + 64 * VP * 2;
    const int lane = tid & 63, w = tid >> 6, fr = lane & 15, fq = lane >> 4;
    bf16x8 qf[NMAP][2];
    { const bf16_t* qr = Qp + (size_t)(16 * w + fr) * qpitch + fq * 8;
#pragma unroll
      for (int mp = 0; mp < NMAP; ++mp)
#pragma unroll
          for (int ks = 0; ks < 2; ++ks) qf[mp][ks] = *(const bf16x8*)(qr + mp * 64 + ks * 32); }
    f32x4 oacc[NMAP][NET], negm[NMAP]; float mrun[NMAP], lsum[NMAP];
#pragma unroll
    for (int mp = 0; mp < NMAP; ++mp) { mrun[mp] = 0.f; lsum[mp] = 0.f; negm[mp] = (f32x4){0.f, 0.f, 0.f, 0.f};
#pragma unroll
        for (int et = 0; et < NET; ++et) oacc[mp][et] = (f32x4){0.f, 0.f, 0.f, 0.f}; }
    const int ntiles = n0 + (t1hi - t1lo);
    u32x4 kreg[NKC], vreg[NVC];
#define ATT_TILE(i) ((i) < n0 ? (i) : t1lo + ((i) - n0))
#define ATT_LOAD(tile) do { const int k0_ = (tile) * 64; \
        _Pragma("unroll") for (int i_ = 0; i_ < NKC; ++i_) { const int c_ = tid + 512 * i_, key_ = c_ / (KW / 8), cc_ = c_ % (KW / 8); kreg[i_] = *(const u32x4*)(Kb + (size_t)(k0_ + key_) * KW + cc_ * 8); } \
        _Pragma("unroll") for (int i_ = 0; i_ < NVC; ++i_) { const int c_ = tid + 512 * i_, key_ = c_ / (VD / 8), cc_ = c_ % (VD / 8); vreg[i_] = *(const u32x4*)(Vt + (size_t)(k0_ + key_) * VD + cc_ * 8); } } while (0)
#define ATT_STORE(buf) do { LAS bf16_t* kS_ = (LAS bf16_t*)(lds + (buf) * BUFB); LAS bf16_t* vS_ = (LAS bf16_t*)(lds + (buf) * BUFB + KBYTES); \
        _Pragma("unroll") for (int i_ = 0; i_ < NKC; ++i_) { const int c_ = tid + 512 * i_, key_ = c_ / (KW / 8), cc_ = c_ % (KW / 8); *(LAS u32x4*)(kS_ + key_ * KP + cc_ * 8) = kreg[i_]; } \
        _Pragma("unroll") for (int i_ = 0; i_ < NVC; ++i_) { const int c_ = tid + 512 * i_, key_ = c_ / (VD / 8), cc_ = c_ % (VD / 8); *(LAS u32x4*)(vS_ + key_ * VP + cc_ * 8) = vreg[i_]; } } while (0)
    ATT_LOAD(ATT_TILE(0));
    ATT_STORE(0);
    if (ntiles > 1) ATT_LOAD(ATT_TILE(1));
    __syncthreads();
    for (int i = 0; i < ntiles; ++i) {
        const int t = ATT_TILE(i);
        if (i + 1 < ntiles) { ATT_STORE((i + 1) & 1); if (i + 2 < ntiles) ATT_LOAD(ATT_TILE(i + 2)); }
        const LAS bf16_t* kS = (const LAS bf16_t*)(lds + (i & 1) * BUFB);
        const LAS bf16_t* vS = (const LAS bf16_t*)(lds + (i & 1) * BUFB + KBYTES);
        bf16x8 pf[NMAP][2];
        f32x4 sacc[NMAP][4];
#pragma unroll
        for (int mp = 0; mp < NMAP; ++mp) {
            bf16x8 kf[4][2];
#pragma unroll
            for (int kt = 0; kt < 4; ++kt)
#pragma unroll
                for (int ks = 0; ks < 2; ++ks) kf[kt][ks] = *(const LAS bf16x8*)(kS + (16 * kt + fr) * KP + mp * KMS + ks * 32 + fq * 8);
            __builtin_amdgcn_sched_barrier(0);
#pragma unroll
            for (int kt = 0; kt < 4; ++kt) sacc[mp][kt] = __builtin_amdgcn_mfma_f32_16x16x32_bf16(kf[kt][0], qf[mp][0], negm[mp], 0, 0, 0);
#pragma unroll
            for (int kt = 0; kt < 4; ++kt) sacc[mp][kt] = __builtin_amdgcn_mfma_f32_16x16x32_bf16(kf[kt][1], qf[mp][1], sacc[mp][kt], 0, 0, 0);
        }
        bf16x8 va[4];
#define ATT_LDV(dst, idx) do { const LAS bf16_t* vp_ = vS + (32 * ((idx) / NET) + 4 * fq + (fr >> 2)) * VP + 16 * ((idx) % NET) + 4 * (fr & 3); \
            const s16x4 lo_ = __builtin_amdgcn_ds_read_tr16_b64_v4i16((LAS s16x4*)vp_), hi_ = __builtin_amdgcn_ds_read_tr16_b64_v4i16((LAS s16x4*)(vp_ + 16 * VP)); \
            dst = (bf16x8){lo_[0], lo_[1], lo_[2], lo_[3], hi_[0], hi_[1], hi_[2], hi_[3]}; } while (0)
#pragma unroll
        for (int i2 = 0; i2 < 4; ++i2) ATT_LDV(va[i2], i2);
        if (SWA && t >= 4) {
            const int dq = qp0 + 16 * w + fr - (64 * (t - 4) + 4 * fq);
#pragma unroll
            for (int kt = 0; kt < 4; ++kt)
#pragma unroll
                for (int r = 0; r < 4; ++r) { const int d = dq - 16 * kt - r; if (d > 128 || d < -128) {
#pragma unroll
                    for (int mp = 0; mp < NMAP; ++mp) sacc[mp][kt][r] = -INFINITY; } }
        }
        float mx[NMAP];
#pragma unroll
        for (int mp = 0; mp < NMAP; ++mp) {
            float v = fmax2(fmax2(sacc[mp][0][0], sacc[mp][0][1]), fmax2(sacc[mp][0][2], sacc[mp][0][3]));
#pragma unroll
            for (int kt = 1; kt < 4; ++kt) v = fmax2(v, fmax2(fmax2(sacc[mp][kt][0], sacc[mp][kt][1]), fmax2(sacc[mp][kt][2], sacc[mp][kt][3])));
            mx[mp] = v;
        }
#pragma unroll
        for (int mp = 0; mp < NMAP; ++mp) mx[mp] = fmax2(mx[mp], __shfl_xor(mx[mp], 16));
#pragma unroll
        for (int mp = 0; mp < NMAP; ++mp) mx[mp] = fmax2(mx[mp], __shfl_xor(mx[mp], 32));
#pragma unroll
        for (int mp = 0; mp < NMAP; ++mp) {
            if (i == 0 || __builtin_amdgcn_ballot_w64(mx[mp] > 8.0f) != 0ull) {
                const float delta = (i == 0) ? mx[mp] : fmaxf(mx[mp], 0.f), alpha = (i == 0) ? 0.f : __builtin_amdgcn_exp2f(-delta);
                mrun[mp] += delta; negm[mp] = (f32x4){-mrun[mp], -mrun[mp], -mrun[mp], -mrun[mp]}; lsum[mp] *= alpha;
#pragma unroll
                for (int kt = 0; kt < 4; ++kt) sacc[mp][kt] = sacc[mp][kt] - delta;
#pragma unroll
                for (int et = 0; et < NET; ++et) oacc[mp][et] = oacc[mp][et] * alpha;
            }
            float ps = 0.f;
#pragma unroll
            for (int kt = 0; kt < 4; ++kt)
#pragma unroll
                for (int r = 0; r < 4; ++r) { const float p = __builtin_amdgcn_exp2f(sacc[mp][kt][r]); sacc[mp][kt][r] = p; ps += p; }
            lsum[mp] += ps;
#pragma unroll
            for (int s2 = 0; s2 < 2; ++s2) {
                u32x4 pk; pk.x = cvt_pk_bf16(sacc[mp][2 * s2][0], sacc[mp][2 * s2][1]); pk.y = cvt_pk_bf16(sacc[mp][2 * s2][2], sacc[mp][2 * s2][3]);
                pk.z = cvt_pk_bf16(sacc[mp][2 * s2 + 1][0], sacc[mp][2 * s2 + 1][1]); pk.w = cvt_pk_bf16(sacc[mp][2 * s2 + 1][2], sacc[mp][2 * s2 + 1][3]);
                pf[mp][s2] = __builtin_bit_cast(bf16x8, pk);
            }
        }
#pragma unroll
        for (int idx = 0; idx < 2 * NET; ++idx) {
            const int et = idx % NET, s2 = idx / NET;
            const bf16x8 cur = va[idx & 3];
            if (idx + 4 < 2 * NET) ATT_LDV(va[idx & 3], idx + 4);
#pragma unroll
            for (int mp = 0; mp < NMAP; ++mp) oacc[mp][et] = __builtin_amdgcn_mfma_f32_16x16x32_bf16(cur, pf[mp][s2], oacc[mp][et], 0, 0, 0);
        }
#undef ATT_LDV
        __syncthreads();
    }
#undef ATT_TILE
#undef ATT_LOAD
#undef ATT_STORE
    float lt[NMAP];
#pragma unroll
    for (int mp = 0; mp < NMAP; ++mp) { float v = lsum[mp]; v += __shfl_xor(v, 16); v += __shfl_xor(v, 32); lt[mp] = v; }
    bf16_t* orow = Op + (size_t)(16 * w + fr) * DM + 4 * fq;
    if constexpr (!SWA) {
        const float inv0 = 1.0f / lt[0], inv1 = lam / lt[1];
        float ss = 0.f;
#pragma unroll
        for (int et = 0; et < NET; ++et)
#pragma unroll
            for (int r = 0; r < 4; ++r) { const float o = oacc[0][et][r] * inv0 - oacc[1][et][r] * inv1; oacc[0][et][r] = o; ss += o * o; }
        ss += __shfl_xor(ss, 16); ss += __shfl_xor(ss, 32);
        const float rstd = rsqrtf(ss * (1.0f / VD) + EPSV) * post_scale;
#pragma unroll
        for (int et = 0; et < NET; ++et) { const f32x4 g = *(const f32x4*)(gsub + 16 * et + 4 * fq); const f32x4 v = oacc[0][et] * rstd * g;
            *(u32x2*)(orow + 16 * et) = (u32x2){cvt_pk_bf16(v[0], v[1]), cvt_pk_bf16(v[2], v[3])}; }
    } else {
#pragma unroll
        for (int mp = 0; mp < NMAP; ++mp) {
            const float l0 = lt[mp] + __builtin_amdgcn_exp2f((mp == 0 ? sink_l2 : lam) - mrun[mp]);
            const float inv = 1.0f / l0;
#pragma unroll
            for (int et = 0; et < NET; ++et) { const f32x4 v = oacc[mp][et] * inv; *(u32x2*)(orow + mp * 64 + 16 * et) = (u32x2){cvt_pk_bf16(v[0], v[1]), cvt_pk_bf16(v[2], v[3])}; }
        }
    }
    __syncthreads();
}

__device__ __forceinline__ void gmlp_unit(LAS unsigned char* lds, const bf16_t* __restrict__ UV, const bf16_t* __restrict__ Wsb  , const float* __restrict__ gain  ,
                                          const float* __restrict__ bs  , int r0, int h, bf16_t* __restrict__ O, int tid) {
    constexpr int VP = 136;
    LAS bf16_t* vT = (LAS bf16_t*)lds;
    const int lane = tid & 63, w = tid >> 6, fr = lane & 15, fq = lane >> 4;
    {
        const int q = tid >> 2, part = tid & 3;
        const bf16_t* src = UV + (size_t)(r0 + q) * 512 + 256 + 64 * h + 16 * part;
        const u32x4 a0 = *(const u32x4*)src, a1 = *(const u32x4*)(src + 8);
        float v[16];
#pragma unroll
        for (int i = 0; i < 4; ++i) { v[2 * i] = __uint_as_float(a0[i] << 16); v[2 * i + 1] = __uint_as_float(a0[i] & 0xffff0000u); v[8 + 2 * i] = __uint_as_float(a1[i] << 16); v[8 + 2 * i + 1] = __uint_as_float(a1[i] & 0xffff0000u); }
        float ss = 0.f;
#pragma unroll
        for (int i = 0; i < 16; ++i) ss += v[i] * v[i];
        ss += __shfl_xor(ss, 1); ss += __shfl_xor(ss, 2);
        const float rstd = rsqrtf(ss * (1.0f / 64.0f) + EPSV);
#pragma unroll
        for (int i = 0; i < 16; ++i) { const int c = 16 * part + i; vT[c * VP + q] = (bf16_t)(cvt_pk_bf16(v[i] * rstd * gain[c], 0.f) & 0xffffu); }
    }
    __syncthreads();
    f32x4 acc[4];
#pragma unroll
    for (int nt = 0; nt < 4; ++nt) acc[nt] = (f32x4){0.f, 0.f, 0.f, 0.f};
#pragma unroll
    for (int ks = 0; ks < 4; ++ks) {
        const bf16x8 wf = *(const bf16x8*)(Wsb + (size_t)(16 * w + fr) * 128 + 32 * ks + 8 * fq);
#pragma unroll
        for (int nt = 0; nt < 4; ++nt) { const bf16x8 vf = *(const LAS bf16x8*)(vT + (16 * nt + fr) * VP + 32 * ks + 8 * fq);
            acc[nt] = __builtin_amdgcn_mfma_f32_16x16x32_bf16(vf, wf, acc[nt], 0, 0, 0); }
    }
    const int p = 16 * w + fr; const float bias = bs[p];
    const bf16_t* up = UV + (size_t)(r0 + p) * 512 + 64 * h + 4 * fq;
    bf16_t* op = O + (size_t)(r0 + p) * DM + 64 * h + 4 * fq;
#pragma unroll
    for (int nt = 0; nt < 4; ++nt) {
        const u32x2 uu = *(const u32x2*)(up + 16 * nt);
        const float u0 = __uint_as_float(uu.x << 16), u1 = __uint_as_float(uu.x & 0xffff0000u), u2 = __uint_as_float(uu.y << 16), u3 = __uint_as_float(uu.y & 0xffff0000u);
        *(u32x2*)(op + 16 * nt) = (u32x2){cvt_pk_bf16(u0 * (acc[nt][0] + bias), u1 * (acc[nt][1] + bias)), cvt_pk_bf16(u2 * (acc[nt][2] + bias), u3 * (acc[nt][3] + bias))};
    }
    __syncthreads();
}

__device__ __forceinline__ void mix_phase(const Args& a, LAS unsigned char* lds, int l, int tid_in, int G) {
    unsigned char* ws = a.ws;
    const bool last = (l == DEPTH - 1);
    const bf16_t* UV = (const bf16_t*)(ws + R1_UV); const bf16_t* QB = (const bf16_t*)(ws + R1_QB); const bf16_t* QC = (const bf16_t*)(ws + R1_QC);
    const bf16_t* KB = (const bf16_t*)(ws + R1_KB); const bf16_t* VBt = (const bf16_t*)(ws + R1_VB); const bf16_t* KC = (const bf16_t*)(ws + R1_KC); const bf16_t* VCt = (const bf16_t*)(ws + R1_VC);
    bf16_t* O = (bf16_t*)(ws + R1_O);
    const float* LAM = (const float*)(ws + WS_LAM);
    const float lam = LAM[l], post_scale = LAM[4 + l];
    const float* gsub = a.in[I_SUBLN] + l * 128;
    const int n_ctxd = last ? 0 : 64, n_ctxs = last ? 0 : 32, n_g = last ? 512 : 576;
    const int e0 = 512, e1 = e0 + 256, e2 = e1 + n_ctxd, e3 = e2 + n_ctxs, e4 = e3 + n_g;
    for (int u = blockIdx.x; u < e4; u += G) {
        int tid = tid_in; asm volatile("" : "+v"(tid));
        if (u < e3) {
            const bool is_swa = (u >= e0 && u < e1) || (u >= e2);
            const bool is_ctx = (u >= e1);
            int b, hh, qb, row0;
            if (u < e0) {
                const int v = u, x = v & 7, slot = (v >> 3) & 31, rnd = v >> 8, P = x * 4 + rnd * 2 + (slot >> 4);
                b = P >> 2; hh = P & 3; qb = slot & 15; row0 = b * SEQ + 128 * qb; }
            else if (u < e1) { const int v = u - e0, x = v & 7, slot = (v >> 3) & 31, P = x * 2 + (slot >> 4); b = P >> 1; hh = P & 1; qb = slot & 15; row0 = b * SEQ + 128 * qb; }
            else if (u < e2) { const int v = u - e1; b = v >> 3; hh = (v >> 1) & 3; qb = v & 1; row0 = T_LAT + b * CTXL + 128 * qb; }
            else { const int v = u - e2; b = v >> 2; hh = (v >> 1) & 1; qb = v & 1; row0 = T_LAT + b * CTXL + 128 * qb; }
            if (!is_swa) {
                attn_unit<2, 128, false>(lds, QB + (size_t)row0 * 512 + hh * 128, 512, KB + (size_t)(b * 4 + hh) * NKEY * 128, VBt + (size_t)(b * 4 + hh) * NKEY * 128,
                                         is_ctx ? 4 : 36, 0, 0, 0, 0.f, lam, gsub, post_scale, O + (size_t)row0 * DM + 256 + hh * 128, tid);
            } else {
                const int kv = hh;
                int lo = 4 + 2 * (qb - 1), hi = 4 + 2 * (qb + 2); if (lo < 4) lo = 4; if (hi > 36) hi = 36;
                if (is_ctx) { lo = 0; hi = 0; }
                attn_unit<2, 64, true>(lds, QC + (size_t)row0 * 256 + kv * 128, 256, KC + (size_t)(b * 2 + kv) * NKEY * 64, VCt + (size_t)(b * 2 + kv) * NKEY * 64,
                                       4, lo, hi, 128 * qb, a.in[I_SINK][l * 4 + kv * 2] * LOG2E, a.in[I_SINK][l * 4 + kv * 2 + 1] * LOG2E, nullptr, 0.f, O + (size_t)row0 * DM + 768 + kv * 128, tid);
            }
        } else {
            const int v = u - e3, ch = v >> 2, h = v & 3;
            gmlp_unit(lds, UV, (const bf16_t*)(ws + WS_WS) + (size_t)(l * 4 + h) * 128 * 128, a.in[I_VGAIN] + (l * 4 + h) * 64, a.in[I_BS] + (l * 4 + h) * 128, ch * 128, h, O, tid);
        }
    }
}

__global__ void __launch_bounds__(512, 2) mega_fwd(Args a) {
    extern __shared__ __attribute__((aligned(16))) unsigned char lds_raw[];
    LAS unsigned char* lds = (LAS unsigned char*)lds_raw;
    cg::grid_group grid = cg::this_grid();
    const int G = gridDim.x;
    volatile LAS unsigned* MISC = (volatile LAS unsigned*)(lds + 131072);
    if (threadIdx.x < 64) MISC[threadIdx.x] = 0u;
    __syncthreads();
    const XcdBarrier xbar = xcd_barrier_post((unsigned*)a.ws, MISC + 8);
    for (int p = a.ph_lo; p < a.ph_hi; ++p) {
        int tid = threadIdx.x; asm volatile("" : "+v"(tid));
        unsigned char* ws = a.ws; asm volatile("" : "+s"(ws));
        if (p == 0) prologue_a(a, lds, tid, G);
        else if (p == 1) norm_phase(a, lds, -1, 0, 0, 0, TT, 0.f, tid, G);
        else {
            const int q = p - 2, l = q / 10, st = q % 10; const bool last = (l == DEPTH - 1);
            const int Mfull = TT, Mlate = last ? T_LAT : TT;
            if (st == 0 || st == 7) {
                const int sub = (st == 7), M = sub ? Mlate : Mfull;
                pg8::Gemm g{(const bf16_t*)(ws + WS_Y), (const bf16_t*)(ws + WS_WGU) + (size_t)(l * 2 + sub) * NGU * DM, M, NGU, DM};
                pg8::StaticOrder S; S.init(M, NGU, G, (int)blockIdx.x); S.nkt = DM / pg8::BK;
                pg8::EpiSwiGLU E{(bf16_t*)(ws + WS_R1)};
                pg8::gemm_phase<pg8::EpiSwiGLU, pg8::StaticOrder, true, true>(lds, g, S, E, tid);
            } else if (st == 1 || st == 8 || st == 5) {
                pg8::Gemm g; int M;
                if (st == 5) { M = Mlate; g = pg8::Gemm{(const bf16_t*)(ws + R1_O), (const bf16_t*)(ws + WS_WOUT) + (size_t)l * DM * DM, M, DM, DM}; }
                else { const int sub = (st == 8); M = sub ? Mlate : Mfull; g = pg8::Gemm{(const bf16_t*)(ws + WS_R1), (const bf16_t*)(ws + WS_WD) + (size_t)(l * 2 + sub) * DM * DFF, M, DM, DFF}; }
                pg8::SplitOrder S; S.init(M, g.K, G, (int)blockIdx.x);
                pg8::EpiZ16 E{(bf16_t*)(ws + WS_Z)};
                pg8::gemm_phase<pg8::EpiZ16, pg8::SplitOrder, true, true>(lds, g, S, E, tid);
            } else if (st == 3) {
                pg8::Gemm g{(const bf16_t*)(ws + WS_Y), (const bf16_t*)(ws + WS_WIN) + (size_t)l * INC * DM, Mfull, INC, DM};
                pg8::StaticOrder S; S.init(Mfull, INC, G, (int)blockIdx.x); S.nkt = DM / pg8::BK;
                pg8::EpiInProj E{(bf16_t*)(ws + R1_UV), (bf16_t*)(ws + R1_QB), (bf16_t*)(ws + R1_QC), (bf16_t*)(ws + R1_KB), (bf16_t*)(ws + R1_VB), (bf16_t*)(ws + R1_KC), (bf16_t*)(ws + R1_VC), (const f32x2*)(ws + WS_ROPE)};
                pg8::gemm_phase<pg8::EpiInProj, pg8::StaticOrder, true, true>(lds, g, S, E, tid);
            } else if (st == 4) {
                mix_phase(a, lds, l, tid, G);
            } else {
                const int j = (st == 2) ? 0 : (st == 6 ? 1 : 2);
                const int l2 = (j == 2) ? l + 1 : l, j2 = (j == 2) ? 0 : j + 1;
                const int nrows = (j == 0) ? Mfull : Mlate;
                norm_phase(a, lds, l, j, l2, j2, nrows, (j == 1) ? 1.0f : 0.5f, tid, G);
            }
        }
        if (p + 1 < a.ph_hi) { if (a.ph_hi > NPHASE) grid.sync(); else xcd_barrier(xbar); }
    }
}

extern "C" void kernel_launch(void* const* d_in, const int* in_sizes, int n_in, void* d_out, int out_size, void* d_ws, size_t ws_size, hipStream_t stream) {
    static int grid = 0;
    if (grid == 0) {
        if (n_in != 19 || out_size != T_LAT * DM || ws_size < WS_NEED) { fprintf(stderr, "kernel_launch: unexpected shapes (n_in %d out %d ws %zu)\n", n_in, out_size, ws_size); grid = -1; return; }
        int dev = 0, cus = 0, per_cu = 0;
        (void)hipGetDevice(&dev);
        (void)hipDeviceGetAttribute(&cus, hipDeviceAttributeMultiprocessorCount, dev);
        if (hipFuncSetAttribute((const void*)mega_fwd, hipFuncAttributeMaxDynamicSharedMemorySize, LDS_BYTES) != hipSuccess) { fprintf(stderr, "kernel_launch: hipFuncSetAttribute failed\n"); grid = -1; return; }
        if (hipOccupancyMaxActiveBlocksPerMultiprocessor(&per_cu, (const void*)mega_fwd, 512, LDS_BYTES) != hipSuccess || per_cu < 1) { fprintf(stderr, "kernel_launch: occupancy query gave %d\n", per_cu); per_cu = 1; }
        (void)hipGetLastError();
        grid = cus * 1;
        if (grid <= 0) grid = 256;
    }
    if (grid < 0) return;
    (void)hipMemsetAsync(d_ws, 0, 65536, stream);
    Args a{};
    for (int i = 0; i < 19; ++i) a.in[i] = (const float*)d_in[i];
    a.out = (float*)d_out; a.ws = (unsigned char*)d_ws; a.ph_lo = 0; a.ph_hi = NPHASE;
    void* args[] = {&a};
    hipError_t e = hipLaunchCooperativeKernel((const void*)mega_fwd, dim3(grid), dim3(512), args, LDS_BYTES, stream);
    if (e != hipSuccess) fprintf(stderr, "kernel_launch: cooperative launch failed: %s (grid %d)\n", hipGetErrorString(e), grid);
}
```

```cpp
#include <hip/hip_runtime.h>
#include <hip/hip_cooperative_groups.h>
#include <cstdio>
#include <cstdint>
namespace cg = cooperative_groups;

#define LAS __attribute__((address_space(3)))
typedef unsigned short bf16_t;
typedef short bf16x8 __attribute__((ext_vector_type(8)));
typedef short s16x4 __attribute__((ext_vector_type(4)));
typedef float f32x4 __attribute__((ext_vector_type(4)));
typedef float f32x2 __attribute__((ext_vector_type(2)));
typedef unsigned u32x4 __attribute__((ext_vector_type(4)));
typedef unsigned u32x2 __attribute__((ext_vector_type(2)));

constexpr int DM = 1024, NB = 8, SEQ = 2048, CTXL = 256, DEPTH = 4, DFF = 2816, NGU = 2 * DFF, INC = 2560, NKEY = SEQ + CTXL;
constexpr int T_LAT = NB * SEQ, T_CTX = NB * CTXL, TT = T_LAT + T_CTX;
constexpr float EPSV = 1e-6f;
constexpr float QSCALE = 0.125f * 1.4426950408889634f;
constexpr float LOG2E = 1.4426950408889634f;

constexpr size_t MiB = 1u << 20;
constexpr size_t WS_MOD = 1 * MiB;
constexpr size_t WS_ROPE = 3 * MiB;
constexpr size_t WS_LAM = 3 * MiB + 65536;
constexpr size_t WS_WS = 4 * MiB;
constexpr size_t WS_WGU = 8 * MiB;
constexpr size_t WS_WD = 96 * MiB;
constexpr size_t WS_WIN = 140 * MiB;
constexpr size_t WS_WOUT = 160 * MiB;
constexpr size_t WS_H = 168 * MiB;
constexpr size_t WS_S16 = 276 * MiB;
constexpr size_t WS_Y = 176 * MiB;
constexpr size_t WS_Z = 212 * MiB;
constexpr size_t WS_R1 = 340 * MiB;
constexpr size_t R1_UV = WS_R1;
constexpr size_t R1_QB = R1_UV + (size_t)TT * 512 * 2;
constexpr size_t R1_QC = R1_QB + (size_t)TT * 512 * 2;
constexpr size_t R1_KB = R1_QC + (size_t)TT * 256 * 2;
constexpr size_t R1_VB = R1_KB + (size_t)NB * 4 * NKEY * 128 * 2;
constexpr size_t R1_KC = R1_VB + (size_t)NB * 4 * NKEY * 128 * 2;
constexpr size_t R1_VC = R1_KC + (size_t)NB * 2 * NKEY * 64 * 2;
constexpr size_t R1_O = R1_VC + (size_t)NB * 2 * NKEY * 64 * 2;
constexpr size_t WS_END = R1_O + (size_t)TT * 1024 * 2;
static_assert(WS_Z + (size_t)(T_LAT + 8 * T_CTX) * DM * 4 <= WS_R1 && WS_R1 + (size_t)TT * DFF * 2 <= 476 * MiB && WS_END <= 476 * MiB, "ws map");
constexpr size_t WS_NEED = 476 * MiB;

constexpr int LDS_BYTES = 131072 + 2048;
constexpr int NPHASE = 2 + 10 * DEPTH;

__device__ __forceinline__ unsigned cvt_pk_bf16(float lo, float hi) { unsigned r; asm volatile("v_cvt_pk_bf16_f32 %0, %1, %2" : "=v"(r) : "v"(lo), "v"(hi)); return r; }
__device__ __forceinline__ float wave_sum(float v) {
    v += __uint_as_float(__builtin_amdgcn_update_dpp(0u, __float_as_uint(v), 0xB1, 0xF, 0xF, true));
    v += __uint_as_float(__builtin_amdgcn_update_dpp(0u, __float_as_uint(v), 0x4E, 0xF, 0xF, true));
    v += __uint_as_float(__builtin_amdgcn_update_dpp(0u, __float_as_uint(v), 0x141, 0xF, 0xF, true));
    v += __uint_as_float(__builtin_amdgcn_update_dpp(0u, __float_as_uint(v), 0x140, 0xF, 0xF, true));
    { const unsigned u = __float_as_uint(v); const auto r = __builtin_amdgcn_permlane16_swap(u, u, false, false); v = __uint_as_float(r[0]) + __uint_as_float(r[1]); }
    { const unsigned u = __float_as_uint(v); const auto r = __builtin_amdgcn_permlane32_swap(u, u, false, false); v = __uint_as_float(r[0]) + __uint_as_float(r[1]); }
    return v;
}
__device__ __forceinline__ float fmax2(float a, float b) { return __builtin_amdgcn_fmed3f(a, b, 3.0e38f); }
__device__ __forceinline__ float silu_f(float g) { return g * __builtin_amdgcn_rcpf(1.f + __expf(-g)); }
__device__ __forceinline__ float gelu_tanh_f(float x) { const float y = 1.5957691216057308f * (x + 0.044715f * x * x * x); return x * __builtin_amdgcn_rcpf(1.f + __expf(-y)); }

namespace pg8 {
constexpr int BM = 256, BK = 64, HALF = 128, HTB = HALF * BK * 2, STAGE_BYTES = 8 * HTB, NXCD = 8, WGM = 8;
__host__ __device__ __forceinline__ int lds_byte(int r, int c) { const int st = (r >> 4) * 2 + (c >> 5), rr = r & 15, cc = c & 31, ob = rr * 64 + cc * 2; return st * 1024 + (ob ^ (((ob >> 9) & 1) << 5)); }
__host__ __device__ __forceinline__ void stage_rc(int b, int& R, int& C) { const int st = b / 1024, sb = b % 1024, swz = sb ^ (((sb >> 9) & 1) << 5); R = (st >> 1) * 16 + swz / 64; C = (st & 1) * 32 + (swz % 64) / 2; }
__host__ __device__ __forceinline__ int perm32(int rho) { const int n = rho >> 4, i = rho & 15; return 8 * (i >> 2) + 4 * n + (i & 3); }

struct Unit { int pm, pn, k0, nk, part; };
struct Gemm { const bf16_t* A; const bf16_t* Bt; int M, N, K; };

struct StaticOrder {
    int nM, nN, nwg, G, c, nkt;
    __host__ __device__ void init(int M, int N, int G_, int c_) { nM = M / BM; nN = N / BM; nwg = nM * nN; G = G_; c = c_; nkt = 0; }
    __host__ __device__ bool next(int i, Unit& u) const {
        const long L = (long)i * G + c; if (L >= nwg) return false;
        int wgid = (int)L; { const int q = nwg / NXCD, r = nwg % NXCD, xcd = wgid % NXCD, off = wgid / NXCD; wgid = (xcd < r ? xcd * (q + 1) : r * (q + 1) + (xcd - r) * q) + off; }
        const int nig = WGM * nN, gid = wgid / nig, fm = gid * WGM, gsz = (nM - fm) < WGM ? (nM - fm) : WGM;
        u.pm = fm + ((wgid % nig) % gsz); u.pn = (wgid % nig) / gsz; u.k0 = 0; u.nk = nkt; u.part = -1; return true;
    }
    __device__ __forceinline__ void a_ready(const Unit&) const {}
    __device__ __forceinline__ void done(const Unit&) const {}
};
struct SplitOrder {
    int G, c, nitems, nkt;
    __host__ __device__ void init(int M, int K, int G_, int c_) { G = G_; c = c_; nkt = K / BK; nitems = 256 + (M > T_LAT ? 256 : 0); }
    __host__ __device__ bool next(int i, Unit& u) const {
        const int L = i * G + c; if (L >= nitems) return false;
        const int w = (L & 7) * 32 + ((L >> 3) & 31), lpm = (w >> 5) * 8 + (w & 7), lpn = (w & 31) >> 3;
        const int v = L - 256, cu = v >> 3, part = v & 7;
        const bool ctx = L >= 256;
        const int ck0 = (nkt == 44) ? (part < 6 ? 6 * part : 36 + 4 * (part - 6)) : part * (nkt >> 3);
        const int cnk = (nkt == 44) ? (part < 6 ? 6 : 4) : (nkt >> 3);
        u.pm = ctx ? 64 + (cu >> 2) : lpm; u.pn = ctx ? (cu & 3) : lpn; u.part = ctx ? part : -1; u.k0 = ctx ? ck0 : 0; u.nk = ctx ? cnk : nkt;
        return true;
    }
    __device__ __forceinline__ void a_ready(const Unit&) const {}
    __device__ __forceinline__ void done(const Unit&) const {}
};


struct EpiSwiGLU {
    static constexpr bool PERM = true, AFTER_DRAIN = false;
    bf16_t* O;
    __device__ __forceinline__ void operator()(const f32x4 (&acc)[2][2][4][2], const Unit& u, int wr, int wc, int fr, int fq) const {
        const int row0 = u.pm * BM + wr * 64 + fr, col0 = u.pn * 128 + wc * 32 + 8 * fq;
#pragma unroll
        for (int ai = 0; ai < 2; ++ai)
#pragma unroll
            for (int m = 0; m < 4; ++m) {
                bf16_t* p = O + (size_t)(row0 + ai * HALF + m * 16) * DFF + col0;
                const f32x4 g0 = acc[ai][0][m][0], g1 = acc[ai][0][m][1], u0 = acc[ai][1][m][0], u1 = acc[ai][1][m][1];
                u32x4 w;
#define SGLU(g_, u_) ((g_) * (u_) * __builtin_amdgcn_rcpf(1.f + __builtin_amdgcn_exp2f(-(g_))))
                w.x = cvt_pk_bf16(SGLU(g0[0], u0[0]), SGLU(g0[1], u0[1])); w.y = cvt_pk_bf16(SGLU(g0[2], u0[2]), SGLU(g0[3], u0[3]));
                w.z = cvt_pk_bf16(SGLU(g1[0], u1[0]), SGLU(g1[1], u1[1])); w.w = cvt_pk_bf16(SGLU(g1[2], u1[2]), SGLU(g1[3], u1[3]));
#undef SGLU
                *(u32x4*)p = w;
            }
    }
};
struct EpiZ16 {
    static constexpr bool PERM = true, AFTER_DRAIN = false;
    bf16_t* Z;
    __device__ __forceinline__ void operator()(const f32x4 (&acc)[2][2][4][2], const Unit& u, int wr, int wc, int fr, int fq) const {
        const int row0 = u.pm * BM + wr * 64 + fr + (u.part > 0 ? u.part * T_CTX : 0), col0 = u.pn * BM + wc * 32 + 8 * fq;
#pragma unroll
        for (int ai = 0; ai < 2; ++ai)
#pragma unroll
            for (int m = 0; m < 4; ++m) {
                bf16_t* p = Z + (size_t)(row0 + ai * HALF + m * 16) * DM + col0;
#pragma unroll
                for (int bj = 0; bj < 2; ++bj) { const f32x4 v0 = acc[ai][bj][m][0], v1 = acc[ai][bj][m][1];
                    *(u32x4*)(p + bj * HALF) = (u32x4){cvt_pk_bf16(v0[0], v0[1]), cvt_pk_bf16(v0[2], v0[3]), cvt_pk_bf16(v1[0], v1[1]), cvt_pk_bf16(v1[2], v1[3])}; }
            }
    }
};
struct EpiInProj {
    static constexpr bool PERM = false, AFTER_DRAIN = false;
    bf16_t *UV, *QB, *QC, *KB, *VBt, *KC, *VCt; const f32x2* rope;
    __device__ __forceinline__ void operator()(const f32x4 (&acc)[2][2][4][2], const Unit& u, int wr, int wc, int fr, int fq) const {
        const int pn = u.pn; const bool lat = u.pm < (T_LAT / BM);
#pragma unroll
        for (int ai = 0; ai < 2; ++ai)
#pragma unroll
            for (int m = 0; m < 4; ++m) {
                const int r = u.pm * BM + ai * HALF + wr * 64 + m * 16 + fr;
                int b, s, keyidx;
                if (lat) { b = r >> 11; s = r & 2047; keyidx = CTXL + s; } else { const int rc = r - T_LAT; b = rc >> 8; s = 0; keyidx = rc & 255; }
                f32x4 c01 = (f32x4){1.f, 0.f, 1.f, 0.f}, c23 = c01;
                if (lat && pn >= 2 && (pn <= 6 || pn == 9)) { const int pos = (wc & 1) ? (s & 63) : (s >> 6); c01 = *(const f32x4*)(rope + pos * 16 + 4 * fq); c23 = *(const f32x4*)(rope + pos * 16 + 4 * fq + 2); }
#pragma unroll
                for (int bj = 0; bj < 2; ++bj) {
                    f32x4 v0 = acc[ai][bj][m][0], v1 = acc[ai][bj][m][1];
                    const bool is_rope = (pn >= 2 && pn <= 6) || (pn == 9 && bj == 0);
                    if (is_rope && lat) {
                        const float cs[4] = {c01[0], c01[2], c23[0], c23[2]}, sn[4] = {c01[1], c01[3], c23[1], c23[3]};
#pragma unroll
                        for (int i = 0; i < 4; ++i) { const float x0 = v0[i], x1 = v1[i]; v0[i] = x0 * cs[i] - x1 * sn[i]; v1[i] = x1 * cs[i] + x0 * sn[i]; }
                    }
                    const int ctb = bj * HALF + wc * 32 + 4 * fq;
                    if (pn <= 1) {
#pragma unroll
                        for (int i = 0; i < 4; ++i) { v0[i] = gelu_tanh_f(v0[i]); v1[i] = gelu_tanh_f(v1[i]); }
                        bf16_t* p = UV + (size_t)r * 512 + pn * 256 + ctb;
                        *(u32x2*)p = (u32x2){cvt_pk_bf16(v0[0], v0[1]), cvt_pk_bf16(v0[2], v0[3])}; *(u32x2*)(p + 16) = (u32x2){cvt_pk_bf16(v1[0], v1[1]), cvt_pk_bf16(v1[2], v1[3])};
                    } else if (pn <= 4) {
                        v0 = v0 * QSCALE; v1 = v1 * QSCALE;
                        bf16_t* p = (pn <= 3) ? QB + (size_t)r * 512 + (pn - 2) * 256 + ctb : QC + (size_t)r * 256 + ctb;
                        *(u32x2*)p = (u32x2){cvt_pk_bf16(v0[0], v0[1]), cvt_pk_bf16(v0[2], v0[3])}; *(u32x2*)(p + 16) = (u32x2){cvt_pk_bf16(v1[0], v1[1]), cvt_pk_bf16(v1[2], v1[3])};
                    } else if (pn <= 6) {
                        const int ck = (pn - 5) * 256 + ctb, head = ck >> 7, cw = ck & 127;
                        bf16_t* p = KB + ((size_t)(b * 4 + head) * NKEY + keyidx) * 128 + cw;
                        *(u32x2*)p = (u32x2){cvt_pk_bf16(v0[0], v0[1]), cvt_pk_bf16(v0[2], v0[3])}; *(u32x2*)(p + 16) = (u32x2){cvt_pk_bf16(v1[0], v1[1]), cvt_pk_bf16(v1[2], v1[3])};
                    } else if (pn <= 8) {
                        const int cv = (pn - 7) * 256 + ctb, head = cv >> 7, e = cv & 127;
                        bf16_t* p = VBt + ((size_t)(b * 4 + head) * NKEY + keyidx) * 128 + e;
                        *(u32x2*)p = (u32x2){cvt_pk_bf16(v0[0], v0[1]), cvt_pk_bf16(v0[2], v0[3])}; *(u32x2*)(p + 16) = (u32x2){cvt_pk_bf16(v1[0], v1[1]), cvt_pk_bf16(v1[2], v1[3])};
                    } else {
                        const int kv = wc >> 1, d = (wc & 1) * 32 + 4 * fq;
                        if (bj == 0) {
                            bf16_t* p = KC + ((size_t)(b * 2 + kv) * NKEY + keyidx) * 64 + d;
                            *(u32x2*)p = (u32x2){cvt_pk_bf16(v0[0], v0[1]), cvt_pk_bf16(v0[2], v0[3])}; *(u32x2*)(p + 16) = (u32x2){cvt_pk_bf16(v1[0], v1[1]), cvt_pk_bf16(v1[2], v1[3])};
                        } else {
                            bf16_t* p = VCt + ((size_t)(b * 2 + kv) * NKEY + keyidx) * 64 + d;
                            *(u32x2*)p = (u32x2){cvt_pk_bf16(v0[0], v0[1]), cvt_pk_bf16(v0[2], v0[3])}; *(u32x2*)(p + 16) = (u32x2){cvt_pk_bf16(v1[0], v1[1]), cvt_pk_bf16(v1[2], v1[3])};
                        }
                    }
                }
                asm volatile("" ::: "memory");
            }
    }
};

template <class Epi, class Sched, bool ALIGN_EPI = false, bool SP2 = false>
__device__ __forceinline__ void gemm_phase(LAS unsigned char* lds, const Gemm g, const Sched& S, const Epi& E, const int tid) {
    const int wid = __builtin_amdgcn_readfirstlane(tid >> 6), lane = tid & 63, wr = wid >> 2, wc = wid & 3, fr = lane & 15, fq = lane >> 4;
    const int K = g.K;
    unsigned voffA[2], voffB[2];
#pragma unroll
    for (int i = 0; i < 2; ++i) { int R, C; stage_rc(tid * 16 + i * 8192, R, C); const int Rb = Epi::PERM ? ((R & ~31) + perm32(R & 31)) : R;
        voffA[i] = (unsigned)(R * K + C) * 2u; voffB[i] = (unsigned)(Rb * K + C) * 2u; }
    const size_t kstep = (size_t)(BK * 2);
    const size_t hstep = (size_t)HALF * K * 2;
    const size_t tstep = 2 * hstep;
    const unsigned ldsw = (unsigned)wid * 1024u;
    const int aoff = lds_byte(wr * 64 + fr, fq * 8), boff = lds_byte(wc * 32 + fr, fq * 8);
#define PG8_SA(b, h) (((b) * 2 + (h)) * HTB)
#define PG8_SB(b, h) ((4 + (b) * 2 + (h)) * HTB)
#define PG8_STAGE(bufoff, gbase, voff) do { _Pragma("unroll") for (int _i = 0; _i < 2; ++_i) \
        __builtin_amdgcn_global_load_lds((const unsigned*)((const char*)(gbase) + (voff)[_i]), (LAS unsigned*)(lds + (bufoff) + ldsw + _i * 8192), 16, 0, 0); } while (0)
#define PG8_LDA(dst, b, h) do { _Pragma("unroll") for (int m = 0; m < 4; ++m) _Pragma("unroll") for (int k = 0; k < 2; ++k) dst[m][k] = *(const LAS bf16x8*)(lds + PG8_SA(b, h) + aoff + m * 2048 + k * 1024); } while (0)
#define PG8_LDB(dst, b, h) do { _Pragma("unroll") for (int n = 0; n < 2; ++n) _Pragma("unroll") for (int k = 0; k < 2; ++k) dst[n][k] = *(const LAS bf16x8*)(lds + PG8_SB(b, h) + boff + n * 2048 + k * 1024); } while (0)
#define PG8_MMA(ai, bj, At, Bt) do { __builtin_amdgcn_s_setprio(1); _Pragma("unroll") for (int m = 0; m < 4; ++m) _Pragma("unroll") for (int n = 0; n < 2; ++n) _Pragma("unroll") for (int k = 0; k < 2; ++k) \
        acc[ai][bj][m][n] = __builtin_amdgcn_mfma_f32_16x16x32_bf16(Bt[n][k], At[m][k], acc[ai][bj][m][n], 0, 0, 0); __builtin_amdgcn_s_setprio(0); } while (0)
#define PG8_WAIT_V(n) asm volatile("s_waitcnt vmcnt(" #n ")" ::: "memory")
#define PG8_WAIT_L(n) asm volatile("s_waitcnt lgkmcnt(" #n ")" ::: "memory")
#define PG8_BAR __builtin_amdgcn_s_barrier()
#define PG8_SCHED __builtin_amdgcn_sched_barrier(0)
    Unit cur, nxt; int ui = 0;
    if (!S.next(0, cur)) return;
    f32x4 acc[2][2][4][2];
#pragma unroll
    for (int a = 0; a < 2; ++a)
#pragma unroll
        for (int b = 0; b < 2; ++b)
#pragma unroll
            for (int m = 0; m < 4; ++m)
#pragma unroll
                for (int n = 0; n < 2; ++n) acc[a][b][m][n] = (f32x4){0.f, 0.f, 0.f, 0.f};
    bf16x8 At[4][2], B0[2][2], B1[2][2];
    const char* cA = (const char*)g.A + (size_t)cur.pm * tstep + (size_t)cur.k0 * kstep; const char* cB = (const char*)g.Bt + (size_t)cur.pn * tstep + (size_t)cur.k0 * kstep;
    S.a_ready(cur);
    if constexpr (SP2) {
        PG8_STAGE(PG8_SB(0, 0), cB, voffB); PG8_STAGE(PG8_SB(0, 1), cB + hstep, voffB); PG8_STAGE(PG8_SA(0, 0), cA, voffA); PG8_STAGE(PG8_SA(0, 1), cA + hstep, voffA);
        if (wr == 1) PG8_BAR;
        PG8_WAIT_V(2); PG8_BAR;
        PG8_STAGE(PG8_SB(1, 0), cB + kstep, voffB); PG8_STAGE(PG8_SA(1, 0), cA + kstep, voffA); PG8_STAGE(PG8_SB(1, 1), cB + hstep + kstep, voffB);
        PG8_WAIT_V(6); PG8_BAR;
    } else {
        PG8_STAGE(PG8_SB(0, 0), cB, voffB); PG8_STAGE(PG8_SA(0, 0), cA, voffA); PG8_STAGE(PG8_SB(0, 1), cB + hstep, voffB); PG8_STAGE(PG8_SA(0, 1), cA + hstep, voffA);
        if (wr == 1) PG8_BAR;
        PG8_WAIT_V(4); PG8_BAR;
        PG8_STAGE(PG8_SB(1, 0), cB + kstep, voffB); PG8_STAGE(PG8_SA(1, 0), cA + kstep, voffA); PG8_STAGE(PG8_SB(1, 1), cB + hstep + kstep, voffB);
        PG8_WAIT_V(6); PG8_BAR;
    }
    for (;;) {
        const bool has_next = S.next(ui + 1, nxt);
        const char* nA = has_next ? (const char*)g.A + (size_t)nxt.pm * tstep + (size_t)nxt.k0 * kstep : cA; const char* nB = has_next ? (const char*)g.Bt + (size_t)nxt.pn * tstep + (size_t)nxt.k0 * kstep : cB;
        const int nt = cur.nk;
        for (int t = 0; t < nt; t += 2) {
            const bool last = (t == nt - 2);
            const char* a1 = cA + (size_t)(t + 1) * kstep;
            const char* a2 = last ? nA : cA + (size_t)(t + 2) * kstep; const char* b2 = last ? nB : cB + (size_t)(t + 2) * kstep;
            const char* a3 = a2 + kstep; const char* b3 = b2 + kstep;
            if (last && has_next) S.a_ready(nxt);
            if constexpr (SP2) {
            PG8_LDB(B0, 0, 0); PG8_LDB(B1, 0, 1); PG8_SCHED; PG8_LDA(At, 0, 0); PG8_STAGE(PG8_SA(1, 1), a1 + hstep, voffA);
            PG8_WAIT_V(8); PG8_WAIT_L(0); PG8_BAR; PG8_MMA(0, 0, At, B0); PG8_MMA(0, 1, At, B1); PG8_BAR; PG8_SCHED;
            PG8_LDA(At, 0, 1); PG8_STAGE(PG8_SB(0, 0), b2, voffB); PG8_STAGE(PG8_SB(0, 1), b2 + hstep, voffB); PG8_STAGE(PG8_SA(0, 0), a2, voffA);
            PG8_WAIT_V(8); PG8_WAIT_L(0); PG8_BAR; PG8_MMA(1, 0, At, B0); PG8_MMA(1, 1, At, B1); PG8_BAR; PG8_SCHED;
            PG8_LDB(B0, 1, 0); PG8_LDB(B1, 1, 1); PG8_SCHED; PG8_LDA(At, 1, 0); PG8_STAGE(PG8_SA(0, 1), a2 + hstep, voffA);
            PG8_WAIT_V(8); PG8_WAIT_L(0); PG8_BAR; PG8_MMA(0, 0, At, B0); PG8_MMA(0, 1, At, B1); PG8_BAR; PG8_SCHED;
            PG8_LDA(At, 1, 1); PG8_STAGE(PG8_SB(1, 0), b3, voffB); PG8_STAGE(PG8_SB(1, 1), b3 + hstep, voffB); PG8_STAGE(PG8_SA(1, 0), a3, voffA);
            PG8_WAIT_V(8); PG8_WAIT_L(0); PG8_BAR; PG8_MMA(1, 0, At, B0); PG8_MMA(1, 1, At, B1); PG8_BAR; PG8_SCHED;
            } else {
            PG8_LDB(B0, 0, 0); PG8_SCHED; PG8_LDA(At, 0, 0); PG8_STAGE(PG8_SA(1, 1), a1 + hstep, voffA);
            PG8_WAIT_L(8); PG8_BAR; PG8_WAIT_L(0); PG8_MMA(0, 0, At, B0); PG8_BAR; PG8_SCHED;
            PG8_LDB(B1, 0, 1); PG8_STAGE(PG8_SB(0, 0), b2, voffB);
            PG8_BAR; PG8_WAIT_L(0); PG8_MMA(0, 1, At, B1); PG8_BAR;
            PG8_LDA(At, 0, 1); PG8_STAGE(PG8_SA(0, 0), a2, voffA);
            PG8_BAR; PG8_WAIT_L(0); PG8_MMA(1, 0, At, B0); PG8_BAR; PG8_SCHED;
            PG8_STAGE(PG8_SB(0, 1), b2 + hstep, voffB);
            PG8_WAIT_V(6); PG8_BAR; PG8_MMA(1, 1, At, B1); PG8_BAR;
            PG8_LDB(B0, 1, 0); PG8_SCHED; PG8_LDA(At, 1, 0); PG8_STAGE(PG8_SA(0, 1), a2 + hstep, voffA);
            PG8_WAIT_L(8); PG8_BAR; PG8_WAIT_L(0); PG8_MMA(0, 0, At, B0); PG8_BAR; PG8_SCHED;
            PG8_LDB(B1, 1, 1); PG8_STAGE(PG8_SB(1, 0), b3, voffB);
            PG8_BAR; PG8_WAIT_L(0); PG8_MMA(0, 1, At, B1); PG8_BAR;
            PG8_LDA(At, 1, 1); PG8_STAGE(PG8_SA(1, 0), a3, voffA);
            PG8_BAR; PG8_WAIT_L(0); PG8_MMA(1, 0, At, B0); PG8_BAR; PG8_SCHED;
            PG8_STAGE(PG8_SB(1, 1), b3 + hstep, voffB);
            PG8_WAIT_V(6); PG8_BAR; PG8_MMA(1, 1, At, B1); PG8_BAR;
            }
        }
        if constexpr (ALIGN_EPI) { if (wr == 0) PG8_BAR; }
        if constexpr (!Epi::AFTER_DRAIN) { E(acc, cur, wr, wc, fr, fq); S.done(cur); }
        if (!has_next) break;
#pragma unroll
        for (int a = 0; a < 2; ++a)
#pragma unroll
            for (int b = 0; b < 2; ++b)
#pragma unroll
                for (int m = 0; m < 4; ++m)
#pragma unroll
                    for (int n = 0; n < 2; ++n) acc[a][b][m][n] = (f32x4){0.f, 0.f, 0.f, 0.f};
        cur = nxt; cA = nA; cB = nB; ++ui;
        if constexpr (ALIGN_EPI) { if (wr == 1) PG8_BAR; }
    }
    PG8_WAIT_V(0);
    if constexpr (!ALIGN_EPI) { if (wr == 0) PG8_BAR; }
    PG8_BAR;
#undef PG8_SA
#undef PG8_SB
#undef PG8_STAGE
#undef PG8_LDA
#undef PG8_LDB
#undef PG8_MMA
#undef PG8_WAIT_V
#undef PG8_WAIT_L
#undef PG8_BAR
#undef PG8_SCHED
}
}


#define XB_TMO      128
#define XB_XCNT(j)  (256  + 64 * (j))
#define XB_XSUB(j)  (1280 + 64 * (j))
#define XB_XGEN(j)  (2304 + 64 * (j))
#define XB_TOP      3328
#define XB_TOPGEN   3392
#define XCD_BAR_WORDS 3456
#define XB_SPIN_CAP (1u << 18)
__device__ __forceinline__ unsigned xb_ld(unsigned* p)              { return __hip_atomic_load(p, __ATOMIC_RELAXED, __HIP_MEMORY_SCOPE_AGENT); }
__device__ __forceinline__ unsigned xb_add(unsigned* p, unsigned v) { return __hip_atomic_fetch_add(p, v, __ATOMIC_RELAXED, __HIP_MEMORY_SCOPE_AGENT); }
__device__ __forceinline__ unsigned xb_xcc_id() { return (unsigned)__builtin_amdgcn_s_getreg((3 << 11) | 20) & 0xFu; }
#define XB_SPIN(cond, bar) do { unsigned _sp = 0; while (cond) { __builtin_amdgcn_s_sleep(1); \
    if ((++_sp & 255u) == 0u) { if (xb_ld(&(bar)[XB_TMO])) break; if (_sp > XB_SPIN_CAP) { atomicAdd(&(bar)[XB_TMO], 1u); break; } } } } while (0)
struct XcdBarrier { unsigned* bar; unsigned x; volatile LAS unsigned* st; };
__device__ __forceinline__ XcdBarrier xcd_barrier_post(unsigned* bar, volatile LAS unsigned* st) {
    XcdBarrier b; b.bar = bar; b.x = xb_xcc_id(); b.st = st;
    if (threadIdx.x == 0) (void)xb_add(&bar[XB_XCNT(b.x)], 1u);
    return b;
}
__device__ __forceinline__ void xcd_barrier_complete(unsigned* bar, unsigned x, unsigned& nloc, unsigned& nx) {
    const unsigned G = gridDim.x * gridDim.y * gridDim.z;
    unsigned sum, cnt, mine, sp = 0u;
    for (;;) {
        sum = 0u; cnt = 0u; mine = 0u;
#pragma unroll
        for (unsigned j = 0; j < 16; ++j) { const unsigned c = xb_ld(&bar[XB_XCNT(j)]); sum += c; cnt += (c > 0u) ? 1u : 0u; mine = (j == x) ? c : mine; }
        if (sum == G) break;
        __builtin_amdgcn_s_sleep(1);
        if ((++sp & 255u) == 0u) { if (xb_ld(&bar[XB_TMO])) break; if (sp > XB_SPIN_CAP) { atomicAdd(&bar[XB_TMO], 1u); break; } }
    }
    nloc = mine > 0u ? mine : 1u; nx = cnt > 0u ? cnt : 1u;
}
__device__ __forceinline__ void xcd_barrier(const XcdBarrier& b) {
    asm volatile("s_waitcnt vmcnt(0)" ::: "memory");
    __syncthreads();
    if (threadIdx.x == 0) {
        unsigned* bar = b.bar;
        __builtin_amdgcn_s_waitcnt(0);
        unsigned nloc = b.st[0], nx = b.st[1];
        if (nloc == 0u) { xcd_barrier_complete(bar, b.x, nloc, nx); b.st[0] = nloc; b.st[1] = nx; }
        const unsigned old = xb_add(&bar[XB_XSUB(b.x)], 1u);
        const unsigned gen = old / nloc;
        if (old + 1u == (gen + 1u) * nloc) {
            __builtin_amdgcn_fence(__ATOMIC_RELEASE, "agent");
            asm volatile("s_waitcnt vmcnt(0)" ::: "memory");
            const unsigned og = xb_add(&bar[XB_TOP], 1u);
            const unsigned tg = og / nx;
            if (og + 1u == (tg + 1u) * nx) xb_add(&bar[XB_TOPGEN], 1u);
            else XB_SPIN(xb_ld(&bar[XB_TOPGEN]) == tg, bar);
            __builtin_amdgcn_fence(__ATOMIC_ACQUIRE, "agent");
            xb_add(&bar[XB_XGEN(b.x)], 1u);
            asm volatile("s_waitcnt vmcnt(0)" ::: "memory");
        } else {
            XB_SPIN(xb_ld(&bar[XB_XGEN(b.x)]) == gen, bar);
            __builtin_amdgcn_fence(__ATOMIC_ACQUIRE, "agent");
            asm volatile("s_waitcnt vmcnt(0)" ::: "memory");
        }
    }
    __syncthreads();
}

struct Args { const float* in[19]; float* out; unsigned char* ws; int ph_lo, ph_hi; };
enum { I_X = 0, I_C, I_CTX, I_CCTX, I_WMOD, I_BMOD, I_NPRE, I_NPOST, I_WG, I_WU, I_WD, I_WIN, I_WOUT, I_VGAIN, I_WS, I_BS, I_LAM, I_SUBLN, I_SINK };

#define LDS_WAIT() asm volatile("s_waitcnt lgkmcnt(0)" ::: "memory")

__device__ __forceinline__ void transpose_item(const float* __restrict__ W, int N, int k0, int n0, bf16_t* __restrict__ WT, int K, int drow0, LAS float* scr, int lane, float wscale = 1.0f) {
#pragma unroll 8
    for (int i = 0; i < 32; ++i) { const int kk = 2 * i + (lane >> 5); scr[kk * 33 + (lane & 31)] = __builtin_nontemporal_load(W + (size_t)(k0 + kk) * N + n0 + (lane & 31)); }
    LDS_WAIT(); asm volatile("" ::: "memory");
    const int c = lane & 7;
#pragma unroll
    for (int j = 0; j < 4; ++j) { const int n = (lane >> 3) + 8 * j; const LAS float* s = scr + (8 * c) * 33 + n;
        u32x4 o; o.x = cvt_pk_bf16(s[0 * 33] * wscale, s[1 * 33] * wscale); o.y = cvt_pk_bf16(s[2 * 33] * wscale, s[3 * 33] * wscale); o.z = cvt_pk_bf16(s[4 * 33] * wscale, s[5 * 33] * wscale); o.w = cvt_pk_bf16(s[6 * 33] * wscale, s[7 * 33] * wscale);
        __builtin_nontemporal_store(o, (u32x4*)(WT + (size_t)(drow0 + n0 + n) * K + k0 + 8 * c)); }
    LDS_WAIT(); asm volatile("" ::: "memory");
}

__device__ __forceinline__ void prologue_a(const Args& a, LAS unsigned char* lds, int tid, int G) {
    const int lane = tid & 63, wave = tid >> 6;
    unsigned char* ws = a.ws;
    {
        LAS float* scr = (LAS float*)(lds + wave * 16384);
        const int gw = blockIdx.x * 8 + wave, NGW = G * 8;
        constexpr int PER_L = 10240;
        for (int it = gw; it < DEPTH * PER_L; it += NGW) {
            const int l = it / PER_L; int r = it % PER_L;
            if (r < 5632) {
                const int up = r >= 2816; if (up) r -= 2816;
                const int sub = r / 1408, rr = r % 1408, kb = rr / 88, nb = rr % 88, n0 = nb * 32;
                const float* W = a.in[up ? I_WU : I_WG] + (size_t)(l * 2 + sub) * DM * DFF;
                bf16_t* WT = (bf16_t*)(ws + WS_WGU) + (size_t)(l * 2 + sub) * NGU * DM;
                transpose_item(W, DFF, kb * 64, n0, WT, DM, 256 * (n0 >> 7) + (up ? 128 : 0) + (n0 & 127) - n0, scr, lane, up ? (1.0f / LOG2E) : LOG2E);
            } else if (r < 8448) {
                r -= 5632; const int sub = r / 1408, rr = r % 1408, kb = rr / 32, nb = rr % 32;
                const float* W = a.in[I_WD] + (size_t)(l * 2 + sub) * DFF * DM;
                bf16_t* WT = (bf16_t*)(ws + WS_WD) + (size_t)(l * 2 + sub) * DM * DFF;
                transpose_item(W, DM, kb * 64, nb * 32, WT, DFF, 0, scr, lane);
            } else if (r < 9728) {
                r -= 8448; const int kb = r / 80, nb = r % 80;
                transpose_item(a.in[I_WIN] + (size_t)l * DM * INC, INC, kb * 64, nb * 32, (bf16_t*)(ws + WS_WIN) + (size_t)l * INC * DM, DM, 0, scr, lane);
            } else {
                r -= 9728; const int kb = r / 32, nb = r % 32;
                transpose_item(a.in[I_WOUT] + (size_t)l * DM * DM, DM, kb * 64, nb * 32, (bf16_t*)(ws + WS_WOUT) + (size_t)l * DM * DM, DM, 0, scr, lane);
            }
        }
        const float* wsrc = a.in[I_WS]; bf16_t* wdst = (bf16_t*)(ws + WS_WS);
        for (int i = (blockIdx.x * 512 + tid); i < DEPTH * 4 * 128 * 128 / 8; i += G * 512) {
            const f32x4 v0 = *(const f32x4*)(wsrc + (size_t)i * 8), v1 = *(const f32x4*)(wsrc + (size_t)i * 8 + 4);
            *(u32x4*)(wdst + (size_t)i * 8) = (u32x4){cvt_pk_bf16(v0[0], v0[1]), cvt_pk_bf16(v0[2], v0[3]), cvt_pk_bf16(v1[0], v1[1]), cvt_pk_bf16(v1[2], v1[3])};
        }
    }
    __syncthreads();
    {
        LAS float* sc = (LAS float*)lds;
        LAS float* red = (LAS float*)(lds + 9 * 1024 * 4);
        for (int i = tid; i < 9 * 1024; i += 512) { const int m = i >> 10, k = i & 1023; const float v = (m < 8) ? a.in[I_C][m * 1024 + k] : a.in[I_CCTX][k]; sc[i] = silu_f(v); }
        __syncthreads();
        float* MOD = (float*)(ws + WS_MOD);
        const int kq = tid >> 7, jj = tid & 127;
        for (int it = blockIdx.x; it < DEPTH * 72; it += G) {
            const int l = it / 72, cb = it % 72, col = cb * 128 + jj;
            const float* wp = a.in[I_WMOD] + (size_t)l * DM * 9216 + col;
            float acc[9];
#pragma unroll
            for (int m = 0; m < 9; ++m) acc[m] = 0.f;
#pragma unroll 4
            for (int k = kq * 256; k < kq * 256 + 256; ++k) {
                const float w = __builtin_nontemporal_load(wp + (size_t)k * 9216);
#pragma unroll
                for (int m = 0; m < 9; ++m) acc[m] += sc[m * 1024 + k] * w;
            }
#pragma unroll
            for (int m = 0; m < 9; ++m) red[(kq * 9 + m) * 128 + jj] = acc[m];
            __syncthreads();
            for (int o = tid; o < 9 * 128; o += 512) { const int m = o >> 7, j2 = o & 127;
                const float v = red[(0 * 9 + m) * 128 + j2] + red[(1 * 9 + m) * 128 + j2] + red[(2 * 9 + m) * 128 + j2] + red[(3 * 9 + m) * 128 + j2];
                MOD[((size_t)l * 9 + m) * 9216 + cb * 128 + j2] = v + a.in[I_BMOD][l * 9216 + cb * 128 + j2]; }
            __syncthreads();
        }
    }
    if (blockIdx.x == 0) {
        f32x2* rope = (f32x2*)(ws + WS_ROPE);
        for (int i = tid; i < 64 * 16; i += 512) { const int pos = i >> 4, j = i & 15; const float inv = powf(10000.0f, -(float)j / 16.0f); const float ang = (float)pos * inv; rope[i] = (f32x2){cosf(ang), sinf(ang)}; }
    }
    if (blockIdx.x == (G > 1 ? 1 : 0) && wave == 0) {
        float* LAM = (float*)(ws + WS_LAM);
        for (int l = 0; l < DEPTH; ++l) {
            const float* lp = a.in[I_LAM] + l * 256;
            const float s1 = wave_sum(lp[lane] * lp[64 + lane]), s2 = wave_sum(lp[128 + lane] * lp[192 + lane]);
            const float lam_init = 0.8f - 0.6f * expf(-0.3f * (float)l);
            if (lane == 0) { LAM[l] = expf(s1) - expf(s2) + lam_init; LAM[4 + l] = 1.0f - lam_init; }
        }
    }
}

__device__ __forceinline__ void unpack8(const u32x4 w, f32x4& lo, f32x4& hi) {
    lo = (f32x4){__uint_as_float(w.x << 16), __uint_as_float(w.x & 0xffff0000u), __uint_as_float(w.y << 16), __uint_as_float(w.y & 0xffff0000u)};
    hi = (f32x4){__uint_as_float(w.z << 16), __uint_as_float(w.z & 0xffff0000u), __uint_as_float(w.w << 16), __uint_as_float(w.w & 0xffff0000u)};
}
__device__ __forceinline__ void norm_phase(const Args& a, LAS unsigned char* lds, int l, int j, int l2, int j2, int nrows, float wgt, int tid, int G) {
    const int lane = tid & 63, wave = tid >> 6;
    unsigned char* ws = a.ws;
    const float* MOD = (const float*)(ws + WS_MOD);
    const bf16_t* Z = (const bf16_t*)(ws + WS_Z);
    bf16_t* S16 = (bf16_t*)(ws + WS_S16);
    bf16_t* Y = (bf16_t*)(ws + WS_Y);
    const int NW = G * 8, gw = blockIdx.x * 8 + wave;
    const int lc = (T_LAT + NW - 1) / NW, cc = (nrows > T_LAT) ? (nrows - T_LAT + NW - 1) / NW : 0;
    const int la = gw * lc < T_LAT ? gw * lc : T_LAT, lb = (la + lc < T_LAT) ? la + lc : T_LAT;
    const int ca0 = T_LAT + gw * cc, ca = ca0 < nrows ? ca0 : nrows, cb = (ca + cc < nrows) ? ca + cc : nrows;
    const int nmine = (lb - la) + (cb - ca);
#define NORM_ROW(i_) ((i_) < lb - la ? la + (i_) : ca + ((i_) - (lb - la)))
    const int cl = 8 * lane;
    const int mfirst = ((int)blockIdx.x * 8 * lc) >> 11, mlastr = ((int)blockIdx.x * 8 + 7) * lc + lc - 1, mlast = (mlastr < T_LAT ? mlastr : T_LAT - 1) >> 11;
    const bool use_lds = (mfirst == mlast) && ((int)blockIdx.x * 8 * lc < T_LAT);
    LAS f32x4* vlds = (LAS f32x4*)lds;
    if (use_lds) {
        const int set = tid >> 8, c4 = tid & 255, mm = set ? 8 : mfirst, c = 4 * c4;
        float z0_ = 0.f; asm volatile("" : "+v"(z0_));
        f32x4 av = (f32x4){z0_, z0_, z0_, z0_}, bv = av, cv = av;
        if (l >= 0) av = *(const f32x4*)(MOD + ((size_t)l * 9 + mm) * 9216 + (3 * j + 2) * DM + c) * *(const f32x4*)(a.in[I_NPOST] + (size_t)(l * 3 + j) * DM + c) * wgt;
        if (l2 < DEPTH) { const float* shift = MOD + ((size_t)l2 * 9 + mm) * 9216 + (3 * j2) * DM;
            bv = *(const f32x4*)(a.in[I_NPRE] + (size_t)(l2 * 3 + j2) * DM + c) * (*(const f32x4*)(shift + DM + c) + 1.0f); cv = *(const f32x4*)(shift + c); }
        vlds[(set * 3 + 0) * 256 + c4] = av; vlds[(set * 3 + 1) * 256 + c4] = bv; vlds[(set * 3 + 2) * 256 + c4] = cv;
    }
    __syncthreads();
    const bool final_out = (l2 >= DEPTH);
    int mcur = -1;
    f32x4 Av[4], Bv[4], Cv[4];
#pragma unroll
    for (int k = 0; k < 4; ++k) { Av[k] = (f32x4){0.f, 0.f, 0.f, 0.f}; Bv[k] = Av[k]; Cv[k] = Av[k]; }
    u32x4 zc0 = (u32x4){0u, 0u, 0u, 0u}, zc1 = zc0, qc0 = zc0, qc1 = zc0; f32x4 xc[4];
#pragma unroll
    for (int k = 0; k < 4; ++k) xc[k] = (f32x4){0.f, 0.f, 0.f, 0.f};
#define NORM_LOAD(row_, z0_, z1_, q0_, q1_, x_) do { \
        if (l < 0) { const float* src_ = ((row_) < T_LAT) ? a.in[I_X] + (size_t)(row_) * DM : a.in[I_CTX] + (size_t)((row_) - T_LAT) * DM; \
            _Pragma("unroll") for (int k = 0; k < 4; ++k) x_[k] = __builtin_nontemporal_load((const f32x4*)(src_ + 512 * (k >> 1) + cl + 4 * (k & 1))); } \
        else { z0_ = __builtin_nontemporal_load((const u32x4*)(Z + (size_t)(row_) * DM + cl)); z1_ = __builtin_nontemporal_load((const u32x4*)(Z + (size_t)(row_) * DM + 512 + cl)); \
            q0_ = __builtin_nontemporal_load((const u32x4*)(S16 + (size_t)(row_) * DM + cl)); q1_ = __builtin_nontemporal_load((const u32x4*)(S16 + (size_t)(row_) * DM + 512 + cl)); } } while (0)
    if (nmine > 0) NORM_LOAD(NORM_ROW(0), zc0, zc1, qc0, qc1, xc);
    for (int ri = 0; ri < nmine; ++ri) {
        const int row = NORM_ROW(ri);
        const bool lat = row < T_LAT;
        const int m = lat ? (row >> 11) : 8;
        u32x4 zn0 = zc0, zn1 = zc1, qn0 = qc0, qn1 = qc1; f32x4 xn[4];
#pragma unroll
        for (int k = 0; k < 4; ++k) xn[k] = xc[k];
        if (ri + 1 < nmine) { const int rown = NORM_ROW(ri + 1); NORM_LOAD(rown, zn0, zn1, qn0, qn1, xn); }
        if (m != mcur && use_lds) {
            mcur = m;
            const int set = (m == 8) ? 1 : 0;
#pragma unroll
            for (int k = 0; k < 4; ++k) { const int c4 = (512 * (k >> 1) + cl + 4 * (k & 1)) >> 2; Av[k] = vlds[(set * 3 + 0) * 256 + c4]; Bv[k] = vlds[(set * 3 + 1) * 256 + c4]; Cv[k] = vlds[(set * 3 + 2) * 256 + c4]; }
        }
        if (m != mcur) {
            mcur = m;
            if (l >= 0) {
                const float* gate = MOD + ((size_t)l * 9 + m) * 9216 + (3 * j + 2) * DM;
                const float* post = a.in[I_NPOST] + (size_t)(l * 3 + j) * DM;
#pragma unroll
                for (int k = 0; k < 4; ++k) { const int c = 512 * (k >> 1) + cl + 4 * (k & 1); Av[k] = *(const f32x4*)(gate + c) * *(const f32x4*)(post + c) * wgt; }
            }
            if (l2 < DEPTH) {
                const float* shift = MOD + ((size_t)l2 * 9 + m) * 9216 + (3 * j2) * DM;
                const float* scale = shift + DM;
                const float* pre = a.in[I_NPRE] + (size_t)(l2 * 3 + j2) * DM;
#pragma unroll
                for (int k = 0; k < 4; ++k) { const int c = 512 * (k >> 1) + cl + 4 * (k & 1); Bv[k] = *(const f32x4*)(pre + c) * (*(const f32x4*)(scale + c) + 1.0f); Cv[k] = *(const f32x4*)(shift + c); }
            }
        }
        f32x4 sv[4];
        if (l < 0) {
#pragma unroll
            for (int k = 0; k < 4; ++k) sv[k] = xc[k];
        } else {
            unpack8(qc0, sv[0], sv[1]); unpack8(qc1, sv[2], sv[3]);
            f32x4 zv[4];
            unpack8(zc0, zv[0], zv[1]); unpack8(zc1, zv[2], zv[3]);
            if (!lat) {
#pragma unroll
                for (int pp = 1; pp < 8; ++pp) { const bf16_t* zp = Z + (size_t)(row + pp * T_CTX) * DM + cl; f32x4 t0, t1, t2, t3;
                    unpack8(*(const u32x4*)zp, t0, t1); unpack8(*(const u32x4*)(zp + 512), t2, t3); zv[0] += t0; zv[1] += t1; zv[2] += t2; zv[3] += t3; }
            }
            float ss = 0.f;
#pragma unroll
            for (int k = 0; k < 4; ++k) ss += (zv[k][0] * zv[k][0] + zv[k][1] * zv[k][1]) + (zv[k][2] * zv[k][2] + zv[k][3] * zv[k][3]);
            ss = wave_sum(ss);
            const float rstd = rsqrtf(ss * (1.0f / DM) + EPSV);
#pragma unroll
            for (int k = 0; k < 4; ++k) sv[k] += Av[k] * (zv[k] * rstd);
        }
        if (final_out) {
            float* orow = a.out + (size_t)row * DM;
#pragma unroll
            for (int k = 0; k < 4; ++k) *(f32x4*)(orow + 512 * (k >> 1) + cl + 4 * (k & 1)) = sv[k];
        } else {
            __builtin_nontemporal_store((u32x4){cvt_pk_bf16(sv[0][0], sv[0][1]), cvt_pk_bf16(sv[0][2], sv[0][3]), cvt_pk_bf16(sv[1][0], sv[1][1]), cvt_pk_bf16(sv[1][2], sv[1][3])}, (u32x4*)(S16 + (size_t)row * DM + cl));
            __builtin_nontemporal_store((u32x4){cvt_pk_bf16(sv[2][0], sv[2][1]), cvt_pk_bf16(sv[2][2], sv[2][3]), cvt_pk_bf16(sv[3][0], sv[3][1]), cvt_pk_bf16(sv[3][2], sv[3][3])}, (u32x4*)(S16 + (size_t)row * DM + 512 + cl));
        }
        if (l2 < DEPTH) {
            float ss = 0.f;
#pragma unroll
            for (int k = 0; k < 4; ++k) ss += (sv[k][0] * sv[k][0] + sv[k][1] * sv[k][1]) + (sv[k][2] * sv[k][2] + sv[k][3] * sv[k][3]);
            ss = wave_sum(ss);
            const float rstd = rsqrtf(ss * (1.0f / DM) + EPSV);
            f32x4 y[4];
#pragma unroll
            for (int k = 0; k < 4; ++k) y[k] = (sv[k] * rstd) * Bv[k] + Cv[k];
            *(u32x4*)(Y + (size_t)row * DM + cl) = (u32x4){cvt_pk_bf16(y[0][0], y[0][1]), cvt_pk_bf16(y[0][2], y[0][3]), cvt_pk_bf16(y[1][0], y[1][1]), cvt_pk_bf16(y[1][2], y[1][3])};
            *(u32x4*)(Y + (size_t)row * DM + 512 + cl) = (u32x4){cvt_pk_bf16(y[2][0], y[2][1]), cvt_pk_bf16(y[2][2], y[2][3]), cvt_pk_bf16(y[3][0], y[3][1]), cvt_pk_bf16(y[3][2], y[3][3])};
        }
        zc0 = zn0; zc1 = zn1; qc0 = qn0; qc1 = qn1;
#pragma unroll
        for (int k = 0; k < 4; ++k) xc[k] = xn[k];
    }
#undef NORM_LOAD
#undef NORM_ROW
}

template <int NMAP, int VD, bool SWA>
__device__ __forceinline__ void attn_unit(LAS unsigned char* lds, const bf16_t* __restrict__ Qp, int qpitch, const bf16_t* __restrict__ Kb, const bf16_t* __restrict__ Vt,
                                          int n0, int t1lo, int t1hi, int qp0, float sink_l2, float lam, const float* __restrict__ gsub, float post_scale, bf16_t* __restrict__ Op, int tid) {
    constexpr int KW = SWA ? 64 : 64 * NMAP, KMS = SWA ? 0 : 64, KP = 144, VP = 144, NKC = KW / 64, NVC = VD / 64, NET = VD / 16;
    constexpr int KBYTES = 64 * KP * 2, BUFB = KBYTES + 64 * VP * 2;
    const int lane = tid & 63, w = tid >> 6, fr = lane & 15, fq = lane >> 4;
    bf16x8 qf[NMAP][2];
    { const bf16_t* qr = Qp + (size_t)(16 * w + fr) * qpitch + fq * 8;
#pragma unroll
      for (int mp = 0; mp < NMAP; ++mp)
#pragma unroll
          for (int ks = 0; ks < 2; ++ks) qf[mp][ks] = *(const bf16x8*)(qr + mp * 64 + ks * 32); }
    f32x4 oacc[NMAP][NET], negm[NMAP]; float mrun[NMAP], lsum[NMAP];
#pragma unroll
    for (int mp = 0; mp < NMAP; ++mp) { mrun[mp] = 0.f; lsum[mp] = 0.f; negm[mp] = (f32x4){0.f, 0.f, 0.f, 0.f};
#pragma unroll
        for (int et = 0; et < NET; ++et) oacc[mp][et] = (f32x4){0.f, 0.f, 0.f, 0.f}; }
    const int ntiles = n0 + (t1hi - t1lo);
    u32x4 kreg[NKC], vreg[NVC];
#define ATT_TILE(i) ((i) < n0 ? (i) : t1lo + ((i) - n0))
#define ATT_LOAD(tile) do { const int k0_ = (tile) * 64; \
        _Pragma("unroll") for (int i_ = 0; i_ < NKC; ++i_) { const int c_ = tid + 512 * i_, key_ = c_ / (KW / 8), cc_ = c_ % (KW / 8); kreg[i_] = *(const u32x4*)(Kb + (size_t)(k0_ + key_) * KW + cc_ * 8); } \
        _Pragma("unroll") for (int i_ = 0; i_ < NVC; ++i_) { const int c_ = tid + 512 * i_, key_ = c_ / (VD / 8), cc_ = c_ % (VD / 8); vreg[i_] = *(const u32x4*)(Vt + (size_t)(k0_ + key_) * VD + cc_ * 8); } } while (0)
#define ATT_STORE(buf) do { LAS bf16_t* kS_ = (LAS bf16_t*)(lds + (buf) * BUFB); LAS bf16_t* vS_ = (LAS bf16_t*)(lds + (buf) * BUFB + KBYTES); \
        _Pragma("unroll") for (int i_ = 0; i_ < NKC; ++i_) { const int c_ = tid + 512 * i_, key_ = c_ / (KW / 8), cc_ = c_ % (KW / 8); *(LAS u32x4*)(kS_ + key_ * KP + cc_ * 8) = kreg[i_]; } \
        _Pragma("unroll") for (int i_ = 0; i_ < NVC; ++i_) { const int c_ = tid + 512 * i_, key_ = c_ / (VD / 8), cc_ = c_ % (VD / 8); *(LAS u32x4*)(vS_ + key_ * VP + cc_ * 8) = vreg[i_]; } } while (0)
    ATT_LOAD(ATT_TILE(0));
    ATT_STORE(0);
    if (ntiles > 1) ATT_LOAD(ATT_TILE(1));
    __syncthreads();
    for (int i = 0; i < ntiles; ++i) {
        const int t = ATT_TILE(i);
        if (i + 1 < ntiles) { ATT_STORE((i + 1) & 1); if (i + 2 < ntiles) ATT_LOAD(ATT_TILE(i + 2)); }
        const LAS bf16_t* kS = (const LAS bf16_t*)(lds + (i & 1) * BUFB);
        const LAS bf16_t* vS = (const LAS bf16_t*)(lds + (i & 1) * BUFB + KBYTES);
        bf16x8 pf[NMAP][2];
        f32x4 sacc[NMAP][4];
#pragma unroll
        for (int mp = 0; mp < NMAP; ++mp) {
            bf16x8 kf[4][2];
#pragma unroll
            for (int kt = 0; kt < 4; ++kt)
#pragma unroll
                for (int ks = 0; ks < 2; ++ks) kf[kt][ks] = *(const LAS bf16x8*)(kS + (16 * kt + fr) * KP + mp * KMS + ks * 32 + fq * 8);
            __builtin_amdgcn_sched_barrier(0);
#pragma unroll
            for (int kt = 0; kt < 4; ++kt) sacc[mp][kt] = __builtin_amdgcn_mfma_f32_16x16x32_bf16(kf[kt][0], qf[mp][0], negm[mp], 0, 0, 0);
#pragma unroll
            for (int kt = 0; kt < 4; ++kt) sacc[mp][kt] = __builtin_amdgcn_mfma_f32_16x16x32_bf16(kf[kt][1], qf[mp][1], sacc[mp][kt], 0, 0, 0);
        }
        bf16x8 va[4];
#define ATT_LDV(dst, idx) do { const LAS bf16_t* vp_ = vS + (32 * ((idx) / NET) + 4 * fq + (fr >> 2)) * VP + 16 * ((idx) % NET) + 4 * (fr & 3); \
            const s16x4 lo_ = __builtin_amdgcn_ds_read_tr16_b64_v4i16((LAS s16x4*)vp_), hi_ = __builtin_amdgcn_ds_read_tr16_b64_v4i16((LAS s16x4*)(vp_ + 16 * VP)); \
            dst = (bf16x8){lo_[0], lo_[1], lo_[2], lo_[3], hi_[0], hi_[1], hi_[2], hi_[3]}; } while (0)
#pragma unroll
        for (int i2 = 0; i2 < 4; ++i2) ATT_LDV(va[i2], i2);
        if (SWA && t >= 4) {
            const int dq = qp0 + 16 * w + fr - (64 * (t - 4) + 4 * fq);
#pragma unroll
            for (int kt = 0; kt < 4; ++kt)
#pragma unroll
                for (int r = 0; r < 4; ++r) { const int d = dq - 16 * kt - r; if (d > 128 || d < -128) {
#pragma unroll
                    for (int mp = 0; mp < NMAP; ++mp) sacc[mp][kt][r] = -INFINITY; } }
        }
        float mx[NMAP];
#pragma unroll
        for (int mp = 0; mp < NMAP; ++mp) {
            float v = fmax2(fmax2(sacc[mp][0][0], sacc[mp][0][1]), fmax2(sacc[mp][0][2], sacc[mp][0][3]));
#pragma unroll
            for (int kt = 1; kt < 4; ++kt) v = fmax2(v, fmax2(fmax2(sacc[mp][kt][0], sacc[mp][kt][1]), fmax2(sacc[mp][kt][2], sacc[mp][kt][3])));
            mx[mp] = v;
        }
#pragma unroll
        for (int mp = 0; mp < NMAP; ++mp) mx[mp] = fmax2(mx[mp], __shfl_xor(mx[mp], 16));
#pragma unroll
        for (int mp = 0; mp < NMAP; ++mp) mx[mp] = fmax2(mx[mp], __shfl_xor(mx[mp], 32));
#pragma unroll
        for (int mp = 0; mp < NMAP; ++mp) {
            if (i == 0 || __builtin_amdgcn_ballot_w64(mx[mp] > 8.0f) != 0ull) {
                const float delta = (i == 0) ? mx[mp] : fmaxf(mx[mp], 0.f), alpha = (i == 0) ? 0.f : __builtin_amdgcn_exp2f(-delta);
                mrun[mp] += delta; negm[mp] = (f32x4){-mrun[mp], -mrun[mp], -mrun[mp], -mrun[mp]}; lsum[mp] *= alpha;
#pragma unroll
                for (int kt = 0; kt < 4; ++kt) sacc[mp][kt] = sacc[mp][kt] - delta;
#pragma unroll
                for (int et = 0; et < NET; ++et) oacc[mp][et] = oacc[mp][et] * alpha;
            }
            float ps = 0.f;
#pragma unroll
            for (int kt = 0; kt < 4; ++kt)
#pragma unroll
                for (int r = 0; r < 4; ++r) { const float p = __builtin_amdgcn_exp2f(sacc[mp][kt][r]); sacc[mp][kt][r] = p; ps += p; }
            lsum[mp] += ps;
#pragma unroll
            for (int s2 = 0; s2 < 2; ++s2) {
                u32x4 pk; pk.x = cvt_pk_bf16(sacc[mp][2 * s2][0], sacc[mp][2 * s2][1]); pk.y = cvt_pk_bf16(sacc[mp][2 * s2][2], sacc[mp][2 * s2][3]);
                pk.z = cvt_pk_bf16(sacc[mp][2 * s2 + 1][0], sacc[mp][2 * s2 + 1][1]); pk.w = cvt_pk_bf16(sacc[mp][2 * s2 + 1][2], sacc[mp][2 * s2 + 1][3]);
                pf[mp][s2] = __builtin_bit_cast(bf16x8, pk);
            }
        }
#pragma unroll
        for (int idx = 0; idx < 2 * NET; ++idx) {
            const int et = idx % NET, s2 = idx / NET;
            const bf16x8 cur = va[idx & 3];
            if (idx + 4 < 2 * NET) ATT_LDV(va[idx & 3], idx + 4);
#pragma unroll
            for (int mp = 0; mp < NMAP; ++mp) oacc[mp][et] = __builtin_amdgcn_mfma_f32_16x16x32_bf16(cur, pf[mp][s2], oacc[mp][et], 0, 0, 0);
        }
#undef ATT_LDV
        __syncthreads();
    }
#undef ATT_TILE
#undef ATT_LOAD
#undef ATT_STORE
    float lt[NMAP];
#pragma unroll
    for (int mp = 0; mp < NMAP; ++mp) { float v = lsum[mp]; v += __shfl_xor(v, 16); v += __shfl_xor(v, 32); lt[mp] = v; }
    bf16_t* orow = Op + (size_t)(16 * w + fr) * DM + 4 * fq;
    if constexpr (!SWA) {
        const float inv0 = 1.0f / lt[0], inv1 = lam / lt[1];
        float ss = 0.f;
#pragma unroll
        for (int et = 0; et < NET; ++et)
#pragma unroll
            for (int r = 0; r < 4; ++r) { const float o = oacc[0][et][r] * inv0 - oacc[1][et][r] * inv1; oacc[0][et][r] = o; ss += o * o; }
        ss += __shfl_xor(ss, 16); ss += __shfl_xor(ss, 32);
        const float rstd = rsqrtf(ss * (1.0f / VD) + EPSV) * post_scale;
#pragma unroll
        for (int et = 0; et < NET; ++et) { const f32x4 g = *(const f32x4*)(gsub + 16 * et + 4 * fq); const f32x4 v = oacc[0][et] * rstd * g;
            *(u32x2*)(orow + 16 * et) = (u32x2){cvt_pk_bf16(v[0], v[1]), cvt_pk_bf16(v[2], v[3])}; }
    } else {
#pragma unroll
        for (int mp = 0; mp < NMAP; ++mp) {
            const float l0 = lt[mp] + __builtin_amdgcn_exp2f((mp == 0 ? sink_l2 : lam) - mrun[mp]);
            const float inv = 1.0f / l0;
#pragma unroll
            for (int et = 0; et < NET; ++et) { const f32x4 v = oacc[mp][et] * inv; *(u32x2*)(orow + mp * 64 + 16 * et) = (u32x2){cvt_pk_bf16(v[0], v[1]), cvt_pk_bf16(v[2], v[3])}; }
        }
    }
    __syncthreads();
}

__device__ __forceinline__ void gmlp_unit(LAS unsigned char* lds, const bf16_t* __restrict__ UV, const bf16_t* __restrict__ Wsb  , const float* __restrict__ gain  ,
                                          const float* __restrict__ bs  , int r0, int h, bf16_t* __restrict__ O, int tid) {
    constexpr int VP = 136;
    LAS bf16_t* vT = (LAS bf16_t*)lds;
    const int lane = tid & 63, w = tid >> 6, fr = lane & 15, fq = lane >> 4;
    {
        const int q = tid >> 2, part = tid & 3;
        const bf16_t* src = UV + (size_t)(r0 + q) * 512 + 256 + 64 * h + 16 * part;
        const u32x4 a0 = *(const u32x4*)src, a1 = *(const u32x4*)(src + 8);
        float v[16];
#pragma unroll
        for (int i = 0; i < 4; ++i) { v[2 * i] = __uint_as_float(a0[i] << 16); v[2 * i + 1] = __uint_as_float(a0[i] & 0xffff0000u); v[8 + 2 * i] = __uint_as_float(a1[i] << 16); v[8 + 2 * i + 1] = __uint_as_float(a1[i] & 0xffff0000u); }
        float ss = 0.f;
#pragma unroll
        for (int i = 0; i < 16; ++i) ss += v[i] * v[i];
        ss += __shfl_xor(ss, 1); ss += __shfl_xor(ss, 2);
        const float rstd = rsqrtf(ss * (1.0f / 64.0f) + EPSV);
#pragma unroll
        for (int i = 0; i < 16; ++i) { const int c = 16 * part + i; vT[c * VP + q] = (bf16_t)(cvt_pk_bf16(v[i] * rstd * gain[c], 0.f) & 0xffffu); }
    }
    __syncthreads();
    f32x4 acc[4];
#pragma unroll
    for (int nt = 0; nt < 4; ++nt) acc[nt] = (f32x4){0.f, 0.f, 0.f, 0.f};
#pragma unroll
    for (int ks = 0; ks < 4; ++ks) {
        const bf16x8 wf = *(const bf16x8*)(Wsb + (size_t)(16 * w + fr) * 128 + 32 * ks + 8 * fq);
#pragma unroll
        for (int nt = 0; nt < 4; ++nt) { const bf16x8 vf = *(const LAS bf16x8*)(vT + (16 * nt + fr) * VP + 32 * ks + 8 * fq);
            acc[nt] = __builtin_amdgcn_mfma_f32_16x16x32_bf16(vf, wf, acc[nt], 0, 0, 0); }
    }
    const int p = 16 * w + fr; const float bias = bs[p];
    const bf16_t* up = UV + (size_t)(r0 + p) * 512 + 64 * h + 4 * fq;
    bf16_t* op = O + (size_t)(r0 + p) * DM + 64 * h + 4 * fq;
#pragma unroll
    for (int nt = 0; nt < 4; ++nt) {
        const u32x2 uu = *(const u32x2*)(up + 16 * nt);
        const float u0 = __uint_as_float(uu.x << 16), u1 = __uint_as_float(uu.x & 0xffff0000u), u2 = __uint_as_float(uu.y << 16), u3 = __uint_as_float(uu.y & 0xffff0000u);
        *(u32x2*)(op + 16 * nt) = (u32x2){cvt_pk_bf16(u0 * (acc[nt][0] + bias), u1 * (acc[nt][1] + bias)), cvt_pk_bf16(u2 * (acc[nt][2] + bias), u3 * (acc[nt][3] + bias))};
    }
    __syncthreads();
}

__device__ __forceinline__ void mix_phase(const Args& a, LAS unsigned char* lds, int l, int tid_in, int G) {
    unsigned char* ws = a.ws;
    const bool last = (l == DEPTH - 1);
    const bf16_t* UV = (const bf16_t*)(ws + R1_UV); const bf16_t* QB = (const bf16_t*)(ws + R1_QB); const bf16_t* QC = (const bf16_t*)(ws + R1_QC);
    const bf16_t* KB = (const bf16_t*)(ws + R1_KB); const bf16_t* VBt = (const bf16_t*)(ws + R1_VB); const bf16_t* KC = (const bf16_t*)(ws + R1_KC); const bf16_t* VCt = (const bf16_t*)(ws + R1_VC);
    bf16_t* O = (bf16_t*)(ws + R1_O);
    const float* LAM = (const float*)(ws + WS_LAM);
    const float lam = LAM[l], post_scale = LAM[4 + l];
    const float* gsub = a.in[I_SUBLN] + l * 128;
    const int n_ctxd = last ? 0 : 64, n_ctxs = last ? 0 : 32, n_g = last ? 512 : 576;
    const int e0 = 512, e1 = e0 + 256, e2 = e1 + n_ctxd, e3 = e2 + n_ctxs, e4 = e3 + n_g;
    for (int u = blockIdx.x; u < e4; u += G) {
        int tid = tid_in; asm volatile("" : "+v"(tid));
        if (u < e3) {
            const bool is_swa = (u >= e0 && u < e1) || (u >= e2);
            const bool is_ctx = (u >= e1);
            int b, hh, qb, row0;
            if (u < e0) {
                const int v = u, x = v & 7, slot = (v >> 3) & 31, rnd = v >> 8, P = x * 4 + rnd * 2 + (slot >> 4);
                b = P >> 2; hh = P & 3; qb = slot & 15; row0 = b * SEQ + 128 * qb; }
            else if (u < e1) { const int v = u - e0, x = v & 7, slot = (v >> 3) & 31, P = x * 2 + (slot >> 4); b = P >> 1; hh = P & 1; qb = slot & 15; row0 = b * SEQ + 128 * qb; }
            else if (u < e2) { const int v = u - e1; b = v >> 3; hh = (v >> 1) & 3; qb = v & 1; row0 = T_LAT + b * CTXL + 128 * qb; }
            else { const int v = u - e2; b = v >> 2; hh = (v >> 1) & 1; qb = v & 1; row0 = T_LAT + b * CTXL + 128 * qb; }
            if (!is_swa) {
                attn_unit<2, 128, false>(lds, QB + (size_t)row0 * 512 + hh * 128, 512, KB + (size_t)(b * 4 + hh) * NKEY * 128, VBt + (size_t)(b * 4 + hh) * NKEY * 128,
                                         is_ctx ? 4 : 36, 0, 0, 0, 0.f, lam, gsub, post_scale, O + (size_t)row0 * DM + 256 + hh * 128, tid);
            } else {
                const int kv = hh;
                int lo = 4 + 2 * (qb - 1), hi = 4 + 2 * (qb + 2); if (lo < 4) lo = 4; if (hi > 36) hi = 36;
                if (is_ctx) { lo = 0; hi = 0; }
                attn_unit<2, 64, true>(lds, QC + (size_t)row0 * 256 + kv * 128, 256, KC + (size_t)(b * 2 + kv) * NKEY * 64, VCt + (size_t)(b * 2 + kv) * NKEY * 64,
                                       4, lo, hi, 128 * qb, a.in[I_SINK][l * 4 + kv * 2] * LOG2E, a.in[I_SINK][l * 4 + kv * 2 + 1] * LOG2E, nullptr, 0.f, O + (size_t)row0 * DM + 768 + kv * 128, tid);
            }
        } else {
            const int v = u - e3, ch = v >> 2, h = v & 3;
            gmlp_unit(lds, UV, (const bf16_t*)(ws + WS_WS) + (size_t)(l * 4 + h) * 128 * 128, a.in[I_VGAIN] + (l * 4 + h) * 64, a.in[I_BS] + (l * 4 + h) * 128, ch * 128, h, O, tid);
        }
    }
}

__global__ void __launch_bounds__(512, 2) mega_fwd(Args a) {
    extern __shared__ __attribute__((aligned(16))) unsigned char lds_raw[];
    LAS unsigned char* lds = (LAS unsigned char*)lds_raw;
    cg::grid_group grid = cg::this_grid();
    const int G = gridDim.x;
    volatile LAS unsigned* MISC = (volatile LAS unsigned*)(lds + 131072);
    if (threadIdx.x < 64) MISC[threadIdx.x] = 0u;
    __syncthreads();
    const XcdBarrier xbar = xcd_barrier_post((unsigned*)a.ws, MISC + 8);
    for (int p = a.ph_lo; p < a.ph_hi; ++p) {
        int tid = threadIdx.x; asm volatile("" : "+v"(tid));
        unsigned char* ws = a.ws; asm volatile("" : "+s"(ws));
        if (p == 0) prologue_a(a, lds, tid, G);
        else if (p == 1) norm_phase(a, lds, -1, 0, 0, 0, TT, 0.f, tid, G);
        else {
            const int q = p - 2, l = q / 10, st = q % 10; const bool last = (l == DEPTH - 1);
            const int Mfull = TT, Mlate = last ? T_LAT : TT;
            if (st == 0 || st == 7) {
                const int sub = (st == 7), M = sub ? Mlate : Mfull;
                pg8::Gemm g{(const bf16_t*)(ws + WS_Y), (const bf16_t*)(ws + WS_WGU) + (size_t)(l * 2 + sub) * NGU * DM, M, NGU, DM};
                pg8::StaticOrder S; S.init(M, NGU, G, (int)blockIdx.x); S.nkt = DM / pg8::BK;
                pg8::EpiSwiGLU E{(bf16_t*)(ws + WS_R1)};
                pg8::gemm_phase<pg8::EpiSwiGLU, pg8::StaticOrder, true, true>(lds, g, S, E, tid);
            } else if (st == 1 || st == 8 || st == 5) {
                pg8::Gemm g; int M;
                if (st == 5) { M = Mlate; g = pg8::Gemm{(const bf16_t*)(ws + R1_O), (const bf16_t*)(ws + WS_WOUT) + (size_t)l * DM * DM, M, DM, DM}; }
                else { const int sub = (st == 8); M = sub ? Mlate : Mfull; g = pg8::Gemm{(const bf16_t*)(ws + WS_R1), (const bf16_t*)(ws + WS_WD) + (size_t)(l * 2 + sub) * DM * DFF, M, DM, DFF}; }
                pg8::SplitOrder S; S.init(M, g.K, G, (int)blockIdx.x);
                pg8::EpiZ16 E{(bf16_t*)(ws + WS_Z)};
                pg8::gemm_phase<pg8::EpiZ16, pg8::SplitOrder, true, true>(lds, g, S, E, tid);
            } else if (st == 3) {
                pg8::Gemm g{(const bf16_t*)(ws + WS_Y), (const bf16_t*)(ws + WS_WIN) + (size_t)l * INC * DM, Mfull, INC, DM};
                pg8::StaticOrder S; S.init(Mfull, INC, G, (int)blockIdx.x); S.nkt = DM / pg8::BK;
                pg8::EpiInProj E{(bf16_t*)(ws + R1_UV), (bf16_t*)(ws + R1_QB), (bf16_t*)(ws + R1_QC), (bf16_t*)(ws + R1_KB), (bf16_t*)(ws + R1_VB), (bf16_t*)(ws + R1_KC), (bf16_t*)(ws + R1_VC), (const f32x2*)(ws + WS_ROPE)};
                pg8::gemm_phase<pg8::EpiInProj, pg8::StaticOrder, true, true>(lds, g, S, E, tid);
            } else if (st == 4) {
                mix_phase(a, lds, l, tid, G);
            } else {
                const int j = (st == 2) ? 0 : (st == 6 ? 1 : 2);
                const int l2 = (j == 2) ? l + 1 : l, j2 = (j == 2) ? 0 : j + 1;
                const int nrows = (j == 0) ? Mfull : Mlate;
                norm_phase(a, lds, l, j, l2, j2, nrows, (j == 1) ? 1.0f : 0.5f, tid, G);
            }
        }
        if (p + 1 < a.ph_hi) { if (a.ph_hi > NPHASE) grid.sync(); else xcd_barrier(xbar); }
    }
}

extern "C" void kernel_launch(void* const* d_in, const int* in_sizes, int n_in, void* d_out, int out_size, void* d_ws, size_t ws_size, hipStream_t stream) {
    static int grid = 0;
    if (grid == 0) {
        if (n_in != 19 || out_size != T_LAT * DM || ws_size < WS_NEED) { fprintf(stderr, "kernel_launch: unexpected shapes (n_in %d out %d ws %zu)\n", n_in, out_size, ws_size); grid = -1; return; }
        int dev = 0, cus = 0, per_cu = 0;
        (void)hipGetDevice(&dev);
        (void)hipDeviceGetAttribute(&cus, hipDeviceAttributeMultiprocessorCount, dev);
        if (hipFuncSetAttribute((const void*)mega_fwd, hipFuncAttributeMaxDynamicSharedMemorySize, LDS_BYTES) != hipSuccess) { fprintf(stderr, "kernel_launch: hipFuncSetAttribute failed\n"); grid = -1; return; }
        if (hipOccupancyMaxActiveBlocksPerMultiprocessor(&per_cu, (const void*)mega_fwd, 512, LDS_BYTES) != hipSuccess || per_cu < 1) { fprintf(stderr, "kernel_launch: occupancy query gave %d\n", per_cu); per_cu = 1; }
        (void)hipGetLastError();
        grid = cus * 1;
        if (grid <= 0) grid = 256;
    }
    if (grid < 0) return;
    (void)hipMemsetAsync(d_ws, 0, 65536, stream);
    Args a{};
    for (int i = 0; i < 19; ++i) a.in[i] = (const float*)d_in[i];
    a.out = (float*)d_out; a.ws = (unsigned char*)d_ws; a.ph_lo = 0; a.ph_hi = NPHASE;
    void* args[] = {&a};
    hipError_t e = hipLaunchCooperativeKernel((const void*)mega_fwd, dim3(grid), dim3(512), args, LDS_BYTES, stream);
    if (e != hipSuccess) fprintf(stderr, "kernel_launch: cooperative launch failed: %s (grid %d)\n", hipGetErrorString(e), grid);
}
```

```cpp
#include <hip/hip_runtime.h>
#include <hip/hip_cooperative_groups.h>
#include <cstdio>
#include <cstdint>
namespace cg = cooperative_groups;

#define LAS __attribute__((address_space(3)))
typedef unsigned short bf16_t;
typedef short bf16x8 __attribute__((ext_vector_type(8)));
typedef short s16x4 __attribute__((ext_vector_type(4)));
typedef float f32x4 __attribute__((ext_vector_type(4)));
typedef float f32x2 __attribute__((ext_vector_type(2)));
typedef unsigned u32x4 __attribute__((ext_vector_type(4)));
typedef unsigned u32x2 __attribute__((ext_vector_type(2)));

constexpr int DM = 1024, NB = 8, SEQ = 2048, CTXL = 256, DEPTH = 4, DFF = 2816, NGU = 2 * DFF, INC = 2560, NKEY = SEQ + CTXL;
constexpr int T_LAT = NB * SEQ, T_CTX = NB * CTXL, TT = T_LAT + T_CTX;
constexpr float EPSV = 1e-6f;
constexpr float QSCALE = 0.125f * 1.4426950408889634f;
constexpr float LOG2E = 1.4426950408889634f;

constexpr size_t MiB = 1u << 20;
constexpr size_t WS_MOD = 1 * MiB;
constexpr size_t WS_ROPE = 3 * MiB;
constexpr size_t WS_LAM = 3 * MiB + 65536;
constexpr size_t WS_WS = 4 * MiB;
constexpr size_t WS_WGU = 8 * MiB;
constexpr size_t WS_WD = 96 * MiB;
constexpr size_t WS_WIN = 140 * MiB;
constexpr size_t WS_WOUT = 160 * MiB;
constexpr size_t WS_H = 168 * MiB;
constexpr size_t WS_S16 = 276 * MiB;
constexpr size_t WS_Y = 176 * MiB;
constexpr size_t WS_Z = 212 * MiB;
constexpr size_t WS_R1 = 340 * MiB;
constexpr size_t R1_UV = WS_R1;
constexpr size_t R1_QB = R1_UV + (size_t)TT * 512 * 2;
constexpr size_t R1_QC = R1_QB + (size_t)TT * 512 * 2;
constexpr size_t R1_KB = R1_QC + (size_t)TT * 256 * 2;
constexpr size_t R1_VB = R1_KB + (size_t)NB * 4 * NKEY * 128 * 2;
constexpr size_t R1_KC = R1_VB + (size_t)NB * 4 * NKEY * 128 * 2;
constexpr size_t R1_VC = R1_KC + (size_t)NB * 2 * NKEY * 64 * 2;
constexpr size_t R1_O = R1_VC + (size_t)NB * 2 * NKEY * 64 * 2;
constexpr size_t WS_END = R1_O + (size_t)TT * 1024 * 2;
static_assert(WS_Z + (size_t)(T_LAT + 8 * T_CTX) * DM * 4 <= WS_R1 && WS_R1 + (size_t)TT * DFF * 2 <= 476 * MiB && WS_END <= 476 * MiB, "ws map");
constexpr size_t WS_NEED = 476 * MiB;

constexpr int LDS_BYTES = 131072 + 2048;
constexpr int NPHASE = 2 + 10 * DEPTH;

__device__ __forceinline__ unsigned cvt_pk_bf16(float lo, float hi) { unsigned r; asm volatile("v_cvt_pk_bf16_f32 %0, %1, %2" : "=v"(r) : "v"(lo), "v"(hi)); return r; }
__device__ __forceinline__ float wave_sum(float v) {
    v += __uint_as_float(__builtin_amdgcn_update_dpp(0u, __float_as_uint(v), 0xB1, 0xF, 0xF, true));
    v += __uint_as_float(__builtin_amdgcn_update_dpp(0u, __float_as_uint(v), 0x4E, 0xF, 0xF, true));
    v += __uint_as_float(__builtin_amdgcn_update_dpp(0u, __float_as_uint(v), 0x141, 0xF, 0xF, true));
    v += __uint_as_float(__builtin_amdgcn_update_dpp(0u, __float_as_uint(v), 0x140, 0xF, 0xF, true));
    { const unsigned u = __float_as_uint(v); const auto r = __builtin_amdgcn_permlane16_swap(u, u, false, false); v = __uint_as_float(r[0]) + __uint_as_float(r[1]); }
    { const unsigned u = __float_as_uint(v); const auto r = __builtin_amdgcn_permlane32_swap(u, u, false, false); v = __uint_as_float(r[0]) + __uint_as_float(r[1]); }
    return v;
}
__device__ __forceinline__ float fmax2(float a, float b) { return __builtin_amdgcn_fmed3f(a, b, 3.0e38f); }
__device__ __forceinline__ float silu_f(float g) { return g * __builtin_amdgcn_rcpf(1.f + __expf(-g)); }
__device__ __forceinline__ float gelu_tanh_f(float x) { const float y = 1.5957691216057308f * (x + 0.044715f * x * x * x); return x * __builtin_amdgcn_rcpf(1.f + __expf(-y)); }

namespace pg8 {
constexpr int BM = 256, BK = 64, HALF = 128, HTB = HALF * BK * 2, STAGE_BYTES = 8 * HTB, NXCD = 8, WGM = 8;
__host__ __device__ __forceinline__ int lds_byte(int r, int c) { const int st = (r >> 4) * 2 + (c >> 5), rr = r & 15, cc = c & 31, ob = rr * 64 + cc * 2; return st * 1024 + (ob ^ (((ob >> 9) & 1) << 5)); }
__host__ __device__ __forceinline__ void stage_rc(int b, int& R, int& C) { const int st = b / 1024, sb = b % 1024, swz = sb ^ (((sb >> 9) & 1) << 5); R = (st >> 1) * 16 + swz / 64; C = (st & 1) * 32 + (swz % 64) / 2; }
__host__ __device__ __forceinline__ int perm32(int rho) { const int n = rho >> 4, i = rho & 15; return 8 * (i >> 2) + 4 * n + (i & 3); }

struct Unit { int pm, pn, k0, nk, part; };
struct Gemm { const bf16_t* A; const bf16_t* Bt; int M, N, K; };

struct StaticOrder {
    int nM, nN, nwg, G, c, nkt;
    __host__ __device__ void init(int M, int N, int G_, int c_) { nM = M / BM; nN = N / BM; nwg = nM * nN; G = G_; c = c_; nkt = 0; }
    __host__ __device__ bool next(int i, Unit& u) const {
        const long L = (long)i * G + c; if (L >= nwg) return false;
        int wgid = (int)L; { const int q = nwg / NXCD, r = nwg % NXCD, xcd = wgid % NXCD, off = wgid / NXCD; wgid = (xcd < r ? xcd * (q + 1) : r * (q + 1) + (xcd - r) * q) + off; }
        const int nig = WGM * nN, gid = wgid / nig, fm = gid * WGM, gsz = (nM - fm) < WGM ? (nM - fm) : WGM;
        u.pm = fm + ((wgid % nig) % gsz); u.pn = (wgid % nig) / gsz; u.k0 = 0; u.nk = nkt; u.part = -1; return true;
    }
    __device__ __forceinline__ void a_ready(const Unit&) const {}
    __device__ __forceinline__ void done(const Unit&) const {}
};
struct SplitOrder {
    int G, c, nitems, nkt;
    __host__ __device__ void init(int M, int K, int G_, int c_) { G = G_; c = c_; nkt = K / BK; nitems = 256 + (M > T_LAT ? 256 : 0); }
    __host__ __device__ bool next(int i, Unit& u) const {
        const int L = i * G + c; if (L >= nitems) return false;
        const int w = (L & 7) * 32 + ((L >> 3) & 31), lpm = (w >> 5) * 8 + (w & 7), lpn = (w & 31) >> 3;
        const int v = L - 256, cu = v >> 3, part = v & 7;
        const bool ctx = L >= 256;
        const int ck0 = (nkt == 44) ? (part < 6 ? 6 * part : 36 + 4 * (part - 6)) : part * (nkt >> 3);
        const int cnk = (nkt == 44) ? (part < 6 ? 6 : 4) : (nkt >> 3);
        u.pm = ctx ? 64 + (cu >> 2) : lpm; u.pn = ctx ? (cu & 3) : lpn; u.part = ctx ? part : -1; u.k0 = ctx ? ck0 : 0; u.nk = ctx ? cnk : nkt;
        return true;
    }
    __device__ __forceinline__ void a_ready(const Unit&) const {}
    __device__ __forceinline__ void done(const Unit&) const {}
};


struct EpiSwiGLU {
    static constexpr bool PERM = true, AFTER_DRAIN = false;
    bf16_t* O;
    __device__ __forceinline__ void operator()(const f32x4 (&acc)[2][2][4][2], const Unit& u, int wr, int wc, int fr, int fq) const {
        const int row0 = u.pm * BM + wr * 64 + fr, col0 = u.pn * 128 + wc * 32 + 8 * fq;
#pragma unroll
        for (int ai = 0; ai < 2; ++ai)
#pragma unroll
            for (int m = 0; m < 4; ++m) {
                bf16_t* p = O + (size_t)(row0 + ai * HALF + m * 16) * DFF + col0;
                const f32x4 g0 = acc[ai][0][m][0], g1 = acc[ai][0][m][1], u0 = acc[ai][1][m][0], u1 = acc[ai][1][m][1];
                u32x4 w;
#define SGLU(g_, u_) ((g_) * (u_) * __builtin_amdgcn_rcpf(1.f + __builtin_amdgcn_exp2f(-(g_))))
                w.x = cvt_pk_bf16(SGLU(g0[0], u0[0]), SGLU(g0[1], u0[1])); w.y = cvt_pk_bf16(SGLU(g0[2], u0[2]), SGLU(g0[3], u0[3]));
                w.z = cvt_pk_bf16(SGLU(g1[0], u1[0]), SGLU(g1[1], u1[1])); w.w = cvt_pk_bf16(SGLU(g1[2], u1[2]), SGLU(g1[3], u1[3]));
#undef SGLU
                *(u32x4*)p = w;
            }
    }
};
struct EpiZ16 {
    static constexpr bool PERM = true, AFTER_DRAIN = false;
    bf16_t* Z;
    __device__ __forceinline__ void operator()(const f32x4 (&acc)[2][2][4][2], const Unit& u, int wr, int wc, int fr, int fq) const {
        const int row0 = u.pm * BM + wr * 64 + fr + (u.part > 0 ? u.part * T_CTX : 0), col0 = u.pn * BM + wc * 32 + 8 * fq;
#pragma unroll
        for (int ai = 0; ai < 2; ++ai)
#pragma unroll
            for (int m = 0; m < 4; ++m) {
                bf16_t* p = Z + (size_t)(row0 + ai * HALF + m * 16) * DM + col0;
#pragma unroll
                for (int bj = 0; bj < 2; ++bj) { const f32x4 v0 = acc[ai][bj][m][0], v1 = acc[ai][bj][m][1];
                    *(u32x4*)(p + bj * HALF) = (u32x4){cvt_pk_bf16(v0[0], v0[1]), cvt_pk_bf16(v0[2], v0[3]), cvt_pk_bf16(v1[0], v1[1]), cvt_pk_bf16(v1[2], v1[3])}; }
            }
    }
};
struct EpiInProj {
    static constexpr bool PERM = false, AFTER_DRAIN = false;
    bf16_t *UV, *QB, *QC, *KB, *VBt, *KC, *VCt; const f32x2* rope;
    __device__ __forceinline__ void operator()(const f32x4 (&acc)[2][2][4][2], const Unit& u, int wr, int wc, int fr, int fq) const {
        const int pn = u.pn; const bool lat = u.pm < (T_LAT / BM);
        const bool do_rope = lat && pn >= 2 && (pn <= 6 || pn == 9);
        float one_ = 1.f, zero_ = 0.f; asm volatile("" : "+v"(one_), "+v"(zero_));
        f32x4 n01 = (f32x4){one_, zero_, one_, zero_}, n23 = n01;
#define ROPE_FETCH(ai_, m_) do { const int s_ = (u.pm * BM + (ai_) * HALF + wr * 64 + (m_) * 16 + fr) & 2047, pos_ = (wc & 1) ? (s_ & 63) : (s_ >> 6); \
            n01 = *(const f32x4*)(rope + pos_ * 16 + 4 * fq); n23 = *(const f32x4*)(rope + pos_ * 16 + 4 * fq + 2); } while (0)
        if (do_rope) ROPE_FETCH(0, 0);
#pragma unroll
        for (int ai = 0; ai < 2; ++ai)
#pragma unroll
            for (int m = 0; m < 4; ++m) {
                const f32x4 c01 = n01, c23 = n23;
                if (do_rope && (ai * 4 + m) < 7) ROPE_FETCH((ai * 4 + m + 1) >> 2, (ai * 4 + m + 1) & 3);
                const int r = u.pm * BM + ai * HALF + wr * 64 + m * 16 + fr;
                int b, s, keyidx;
                if (lat) { b = r >> 11; s = r & 2047; keyidx = CTXL + s; } else { const int rc = r - T_LAT; b = rc >> 8; s = 0; keyidx = rc & 255; }
#pragma unroll
                for (int bj = 0; bj < 2; ++bj) {
                    f32x4 v0 = acc[ai][bj][m][0], v1 = acc[ai][bj][m][1];
                    const bool is_rope = (pn >= 2 && pn <= 6) || (pn == 9 && bj == 0);
                    if (is_rope && lat) {
                        const float cs[4] = {c01[0], c01[2], c23[0], c23[2]}, sn[4] = {c01[1], c01[3], c23[1], c23[3]};
#pragma unroll
                        for (int i = 0; i < 4; ++i) { const float x0 = v0[i], x1 = v1[i]; v0[i] = x0 * cs[i] - x1 * sn[i]; v1[i] = x1 * cs[i] + x0 * sn[i]; }
                    }
                    const int ctb = bj * HALF + wc * 32 + 4 * fq;
                    if (pn <= 1) {
#pragma unroll
                        for (int i = 0; i < 4; ++i) { v0[i] = gelu_tanh_f(v0[i]); v1[i] = gelu_tanh_f(v1[i]); }
                        bf16_t* p = UV + (size_t)r * 512 + pn * 256 + ctb;
                        *(u32x2*)p = (u32x2){cvt_pk_bf16(v0[0], v0[1]), cvt_pk_bf16(v0[2], v0[3])}; *(u32x2*)(p + 16) = (u32x2){cvt_pk_bf16(v1[0], v1[1]), cvt_pk_bf16(v1[2], v1[3])};
                    } else if (pn <= 4) {
                        v0 = v0 * QSCALE; v1 = v1 * QSCALE;
                        bf16_t* p = (pn <= 3) ? QB + (size_t)r * 512 + (pn - 2) * 256 + ctb : QC + (size_t)r * 256 + ctb;
                        *(u32x2*)p = (u32x2){cvt_pk_bf16(v0[0], v0[1]), cvt_pk_bf16(v0[2], v0[3])}; *(u32x2*)(p + 16) = (u32x2){cvt_pk_bf16(v1[0], v1[1]), cvt_pk_bf16(v1[2], v1[3])};
                    } else if (pn <= 6) {
                        const int ck = (pn - 5) * 256 + ctb, head = ck >> 7, cw = ck & 127;
                        bf16_t* p = KB + ((size_t)(b * 4 + head) * NKEY + keyidx) * 128 + cw;
                        *(u32x2*)p = (u32x2){cvt_pk_bf16(v0[0], v0[1]), cvt_pk_bf16(v0[2], v0[3])}; *(u32x2*)(p + 16) = (u32x2){cvt_pk_bf16(v1[0], v1[1]), cvt_pk_bf16(v1[2], v1[3])};
                    } else if (pn <= 8) {
                        const int cv = (pn - 7) * 256 + ctb, head = cv >> 7, e = cv & 127;
                        bf16_t* p = VBt + ((size_t)(b * 4 + head) * NKEY + keyidx) * 128 + e;
                        *(u32x2*)p = (u32x2){cvt_pk_bf16(v0[0], v0[1]), cvt_pk_bf16(v0[2], v0[3])}; *(u32x2*)(p + 16) = (u32x2){cvt_pk_bf16(v1[0], v1[1]), cvt_pk_bf16(v1[2], v1[3])};
                    } else {
                        const int kv = wc >> 1, d = (wc & 1) * 32 + 4 * fq;
                        if (bj == 0) {
                            bf16_t* p = KC + ((size_t)(b * 2 + kv) * NKEY + keyidx) * 64 + d;
                            *(u32x2*)p = (u32x2){cvt_pk_bf16(v0[0], v0[1]), cvt_pk_bf16(v0[2], v0[3])}; *(u32x2*)(p + 16) = (u32x2){cvt_pk_bf16(v1[0], v1[1]), cvt_pk_bf16(v1[2], v1[3])};
                        } else {
                            bf16_t* p = VCt + ((size_t)(b * 2 + kv) * NKEY + keyidx) * 64 + d;
                            *(u32x2*)p = (u32x2){cvt_pk_bf16(v0[0], v0[1]), cvt_pk_bf16(v0[2], v0[3])}; *(u32x2*)(p + 16) = (u32x2){cvt_pk_bf16(v1[0], v1[1]), cvt_pk_bf16(v1[2], v1[3])};
                        }
                    }
                }
                asm volatile("" ::: "memory");
            }
    }
};

#undef ROPE_FETCH
template <class Epi, class Sched, bool ALIGN_EPI = false, bool SP2 = false>
__device__ __forceinline__ void gemm_phase(LAS unsigned char* lds, const Gemm g, const Sched& S, const Epi& E, const int tid) {
    const int wid = __builtin_amdgcn_readfirstlane(tid >> 6), lane = tid & 63, wr = wid >> 2, wc = wid & 3, fr = lane & 15, fq = lane >> 4;
    const int K = g.K;
    unsigned voffA[2], voffB[2];
#pragma unroll
    for (int i = 0; i < 2; ++i) { int R, C; stage_rc(tid * 16 + i * 8192, R, C); const int Rb = Epi::PERM ? ((R & ~31) + perm32(R & 31)) : R;
        voffA[i] = (unsigned)(R * K + C) * 2u; voffB[i] = (unsigned)(Rb * K + C) * 2u; }
    const size_t kstep = (size_t)(BK * 2);
    const size_t hstep = (size_t)HALF * K * 2;
    const size_t tstep = 2 * hstep;
    const unsigned ldsw = (unsigned)wid * 1024u;
    const int aoff = lds_byte(wr * 64 + fr, fq * 8), boff = lds_byte(wc * 32 + fr, fq * 8);
#define PG8_SA(b, h) (((b) * 2 + (h)) * HTB)
#define PG8_SB(b, h) ((4 + (b) * 2 + (h)) * HTB)
#define PG8_STAGE(bufoff, gbase, voff) do { _Pragma("unroll") for (int _i = 0; _i < 2; ++_i) \
        __builtin_amdgcn_global_load_lds((const unsigned*)((const char*)(gbase) + (voff)[_i]), (LAS unsigned*)(lds + (bufoff) + ldsw + _i * 8192), 16, 0, 0); } while (0)
#define PG8_LDA(dst, b, h) do { _Pragma("unroll") for (int m = 0; m < 4; ++m) _Pragma("unroll") for (int k = 0; k < 2; ++k) dst[m][k] = *(const LAS bf16x8*)(lds + PG8_SA(b, h) + aoff + m * 2048 + k * 1024); } while (0)
#define PG8_LDB(dst, b, h) do { _Pragma("unroll") for (int n = 0; n < 2; ++n) _Pragma("unroll") for (int k = 0; k < 2; ++k) dst[n][k] = *(const LAS bf16x8*)(lds + PG8_SB(b, h) + boff + n * 2048 + k * 1024); } while (0)
#define PG8_MMA(ai, bj, At, Bt) do { __builtin_amdgcn_s_setprio(1); _Pragma("unroll") for (int m = 0; m < 4; ++m) _Pragma("unroll") for (int n = 0; n < 2; ++n) _Pragma("unroll") for (int k = 0; k < 2; ++k) \
        acc[ai][bj][m][n] = __builtin_amdgcn_mfma_f32_16x16x32_bf16(Bt[n][k], At[m][k], acc[ai][bj][m][n], 0, 0, 0); __builtin_amdgcn_s_setprio(0); } while (0)
#define PG8_WAIT_V(n) asm volatile("s_waitcnt vmcnt(" #n ")" ::: "memory")
#define PG8_WAIT_L(n) asm volatile("s_waitcnt lgkmcnt(" #n ")" ::: "memory")
#define PG8_BAR __builtin_amdgcn_s_barrier()
#define PG8_SCHED __builtin_amdgcn_sched_barrier(0)
    Unit cur, nxt; int ui = 0;
    if (!S.next(0, cur)) return;
    f32x4 acc[2][2][4][2];
#pragma unroll
    for (int a = 0; a < 2; ++a)
#pragma unroll
        for (int b = 0; b < 2; ++b)
#pragma unroll
            for (int m = 0; m < 4; ++m)
#pragma unroll
                for (int n = 0; n < 2; ++n) acc[a][b][m][n] = (f32x4){0.f, 0.f, 0.f, 0.f};
    bf16x8 At[4][2], B0[2][2], B1[2][2];
    const char* cA = (const char*)g.A + (size_t)cur.pm * tstep + (size_t)cur.k0 * kstep; const char* cB = (const char*)g.Bt + (size_t)cur.pn * tstep + (size_t)cur.k0 * kstep;
    S.a_ready(cur);
    if constexpr (SP2) {
        PG8_STAGE(PG8_SB(0, 0), cB, voffB); PG8_STAGE(PG8_SB(0, 1), cB + hstep, voffB); PG8_STAGE(PG8_SA(0, 0), cA, voffA); PG8_STAGE(PG8_SA(0, 1), cA + hstep, voffA);
        if (wr == 1) PG8_BAR;
        PG8_WAIT_V(2); PG8_BAR;
        PG8_STAGE(PG8_SB(1, 0), cB + kstep, voffB); PG8_STAGE(PG8_SA(1, 0), cA + kstep, voffA); PG8_STAGE(PG8_SB(1, 1), cB + hstep + kstep, voffB);
        PG8_WAIT_V(6); PG8_BAR;
    } else {
        PG8_STAGE(PG8_SB(0, 0), cB, voffB); PG8_STAGE(PG8_SA(0, 0), cA, voffA); PG8_STAGE(PG8_SB(0, 1), cB + hstep, voffB); PG8_STAGE(PG8_SA(0, 1), cA + hstep, voffA);
        if (wr == 1) PG8_BAR;
        PG8_WAIT_V(4); PG8_BAR;
        PG8_STAGE(PG8_SB(1, 0), cB + kstep, voffB); PG8_STAGE(PG8_SA(1, 0), cA + kstep, voffA); PG8_STAGE(PG8_SB(1, 1), cB + hstep + kstep, voffB);
        PG8_WAIT_V(6); PG8_BAR;
    }
    for (;;) {
        const bool has_next = S.next(ui + 1, nxt);
        const char* nA = has_next ? (const char*)g.A + (size_t)nxt.pm * tstep + (size_t)nxt.k0 * kstep : cA; const char* nB = has_next ? (const char*)g.Bt + (size_t)nxt.pn * tstep + (size_t)nxt.k0 * kstep : cB;
        const int nt = cur.nk;
        for (int t = 0; t < nt; t += 2) {
            const bool last = (t == nt - 2);
            const char* a1 = cA + (size_t)(t + 1) * kstep;
            const char* a2 = last ? nA : cA + (size_t)(t + 2) * kstep; const char* b2 = last ? nB : cB + (size_t)(t + 2) * kstep;
            const char* a3 = a2 + kstep; const char* b3 = b2 + kstep;
            if (last && has_next) S.a_ready(nxt);
            if constexpr (SP2) {
            PG8_LDB(B0, 0, 0); PG8_LDB(B1, 0, 1); PG8_SCHED; PG8_LDA(At, 0, 0); PG8_STAGE(PG8_SA(1, 1), a1 + hstep, voffA);
            PG8_WAIT_V(8); PG8_WAIT_L(0); PG8_BAR; PG8_MMA(0, 0, At, B0); PG8_MMA(0, 1, At, B1); PG8_BAR; PG8_SCHED;
            PG8_LDA(At, 0, 1); PG8_STAGE(PG8_SB(0, 0), b2, voffB); PG8_STAGE(PG8_SB(0, 1), b2 + hstep, voffB); PG8_STAGE(PG8_SA(0, 0), a2, voffA);
            PG8_WAIT_V(8); PG8_WAIT_L(0); PG8_BAR; PG8_MMA(1, 0, At, B0); PG8_MMA(1, 1, At, B1); PG8_BAR; PG8_SCHED;
            PG8_LDB(B0, 1, 0); PG8_LDB(B1, 1, 1); PG8_SCHED; PG8_LDA(At, 1, 0); PG8_STAGE(PG8_SA(0, 1), a2 + hstep, voffA);
            PG8_WAIT_V(8); PG8_WAIT_L(0); PG8_BAR; PG8_MMA(0, 0, At, B0); PG8_MMA(0, 1, At, B1); PG8_BAR; PG8_SCHED;
            PG8_LDA(At, 1, 1); PG8_STAGE(PG8_SB(1, 0), b3, voffB); PG8_STAGE(PG8_SB(1, 1), b3 + hstep, voffB); PG8_STAGE(PG8_SA(1, 0), a3, voffA);
            PG8_WAIT_V(8); PG8_WAIT_L(0); PG8_BAR; PG8_MMA(1, 0, At, B0); PG8_MMA(1, 1, At, B1); PG8_BAR; PG8_SCHED;
            } else {
            PG8_LDB(B0, 0, 0); PG8_SCHED; PG8_LDA(At, 0, 0); PG8_STAGE(PG8_SA(1, 1), a1 + hstep, voffA);
            PG8_WAIT_L(8); PG8_BAR; PG8_WAIT_L(0); PG8_MMA(0, 0, At, B0); PG8_BAR; PG8_SCHED;
            PG8_LDB(B1, 0, 1); PG8_STAGE(PG8_SB(0, 0), b2, voffB);
            PG8_BAR; PG8_WAIT_L(0); PG8_MMA(0, 1, At, B1); PG8_BAR;
            PG8_LDA(At, 0, 1); PG8_STAGE(PG8_SA(0, 0), a2, voffA);
            PG8_BAR; PG8_WAIT_L(0); PG8_MMA(1, 0, At, B0); PG8_BAR; PG8_SCHED;
            PG8_STAGE(PG8_SB(0, 1), b2 + hstep, voffB);
            PG8_WAIT_V(6); PG8_BAR; PG8_MMA(1, 1, At, B1); PG8_BAR;
            PG8_LDB(B0, 1, 0); PG8_SCHED; PG8_LDA(At, 1, 0); PG8_STAGE(PG8_SA(0, 1), a2 + hstep, voffA);
            PG8_WAIT_L(8); PG8_BAR; PG8_WAIT_L(0); PG8_MMA(0, 0, At, B0); PG8_BAR; PG8_SCHED;
            PG8_LDB(B1, 1, 1); PG8_STAGE(PG8_SB(1, 0), b3, voffB);
            PG8_BAR; PG8_WAIT_L(0); PG8_MMA(0, 1, At, B1); PG8_BAR;
            PG8_LDA(At, 1, 1); PG8_STAGE(PG8_SA(1, 0), a3, voffA);
            PG8_BAR; PG8_WAIT_L(0); PG8_MMA(1, 0, At, B0); PG8_BAR; PG8_SCHED;
            PG8_STAGE(PG8_SB(1, 1), b3 + hstep, voffB);
            PG8_WAIT_V(6); PG8_BAR; PG8_MMA(1, 1, At, B1); PG8_BAR;
            }
        }
        if constexpr (ALIGN_EPI) { if (wr == 0) PG8_BAR; }
        if constexpr (!Epi::AFTER_DRAIN) { E(acc, cur, wr, wc, fr, fq); S.done(cur); }
        if (!has_next) break;
#pragma unroll
        for (int a = 0; a < 2; ++a)
#pragma unroll
            for (int b = 0; b < 2; ++b)
#pragma unroll
                for (int m = 0; m < 4; ++m)
#pragma unroll
                    for (int n = 0; n < 2; ++n) acc[a][b][m][n] = (f32x4){0.f, 0.f, 0.f, 0.f};
        cur = nxt; cA = nA; cB = nB; ++ui;
        if constexpr (ALIGN_EPI) { if (wr == 1) PG8_BAR; }
    }
    PG8_WAIT_V(0);
    if constexpr (!ALIGN_EPI) { if (wr == 0) PG8_BAR; }
    PG8_BAR;
#undef PG8_SA
#undef PG8_SB
#undef PG8_STAGE
#undef PG8_LDA
#undef PG8_LDB
#undef PG8_MMA
#undef PG8_WAIT_V
#undef PG8_WAIT_L
#undef PG8_BAR
#undef PG8_SCHED
}
}


#define XB_TMO      128
#define XB_XCNT(j)  (256  + 64 * (j))
#define XB_XSUB(j)  (1280 + 64 * (j))
#define XB_XGEN(j)  (2304 + 64 * (j))
#define XB_TOP      3328
#define XB_TOPGEN   3392
#define XCD_BAR_WORDS 3456
#define XB_SPIN_CAP (1u << 18)
__device__ __forceinline__ unsigned xb_ld(unsigned* p)              { return __hip_atomic_load(p, __ATOMIC_RELAXED, __HIP_MEMORY_SCOPE_AGENT); }
__device__ __forceinline__ unsigned xb_add(unsigned* p, unsigned v) { return __hip_atomic_fetch_add(p, v, __ATOMIC_RELAXED, __HIP_MEMORY_SCOPE_AGENT); }
__device__ __forceinline__ unsigned xb_xcc_id() { return (unsigned)__builtin_amdgcn_s_getreg((3 << 11) | 20) & 0xFu; }
#define XB_SPIN(cond, bar) do { unsigned _sp = 0; while (cond) { __builtin_amdgcn_s_sleep(1); \
    if ((++_sp & 255u) == 0u) { if (xb_ld(&(bar)[XB_TMO])) break; if (_sp > XB_SPIN_CAP) { atomicAdd(&(bar)[XB_TMO], 1u); break; } } } } while (0)
struct XcdBarrier { unsigned* bar; unsigned x; volatile LAS unsigned* st; };
__device__ __forceinline__ XcdBarrier xcd_barrier_post(unsigned* bar, volatile LAS unsigned* st) {
    XcdBarrier b; b.bar = bar; b.x = xb_xcc_id(); b.st = st;
    if (threadIdx.x == 0) (void)xb_add(&bar[XB_XCNT(b.x)], 1u);
    return b;
}
__device__ __forceinline__ void xcd_barrier_complete(unsigned* bar, unsigned x, unsigned& nloc, unsigned& nx) {
    const unsigned G = gridDim.x * gridDim.y * gridDim.z;
    unsigned sum, cnt, mine, sp = 0u;
    for (;;) {
        sum = 0u; cnt = 0u; mine = 0u;
#pragma unroll
        for (unsigned j = 0; j < 16; ++j) { const unsigned c = xb_ld(&bar[XB_XCNT(j)]); sum += c; cnt += (c > 0u) ? 1u : 0u; mine = (j == x) ? c : mine; }
        if (sum == G) break;
        __builtin_amdgcn_s_sleep(1);
        if ((++sp & 255u) == 0u) { if (xb_ld(&bar[XB_TMO])) break; if (sp > XB_SPIN_CAP) { atomicAdd(&bar[XB_TMO], 1u); break; } }
    }
    nloc = mine > 0u ? mine : 1u; nx = cnt > 0u ? cnt : 1u;
}
__device__ __forceinline__ void xcd_barrier(const XcdBarrier& b) {
    asm volatile("s_waitcnt vmcnt(0)" ::: "memory");
    __syncthreads();
    if (threadIdx.x == 0) {
        unsigned* bar = b.bar;
        __builtin_amdgcn_s_waitcnt(0);
        unsigned nloc = b.st[0], nx = b.st[1];
        if (nloc == 0u) { xcd_barrier_complete(bar, b.x, nloc, nx); b.st[0] = nloc; b.st[1] = nx; }
        const unsigned old = xb_add(&bar[XB_XSUB(b.x)], 1u);
        const unsigned gen = old / nloc;
        if (old + 1u == (gen + 1u) * nloc) {
            __builtin_amdgcn_fence(__ATOMIC_RELEASE, "agent");
            asm volatile("s_waitcnt vmcnt(0)" ::: "memory");
            const unsigned og = xb_add(&bar[XB_TOP], 1u);
            const unsigned tg = og / nx;
            if (og + 1u == (tg + 1u) * nx) xb_add(&bar[XB_TOPGEN], 1u);
            else XB_SPIN(xb_ld(&bar[XB_TOPGEN]) == tg, bar);
            __builtin_amdgcn_fence(__ATOMIC_ACQUIRE, "agent");
            xb_add(&bar[XB_XGEN(b.x)], 1u);
            asm volatile("s_waitcnt vmcnt(0)" ::: "memory");
        } else {
            XB_SPIN(xb_ld(&bar[XB_XGEN(b.x)]) == gen, bar);
            __builtin_amdgcn_fence(__ATOMIC_ACQUIRE, "agent");
            asm volatile("s_waitcnt vmcnt(0)" ::: "memory");
        }
    }
    __syncthreads();
}

struct Args { const float* in[19]; float* out; unsigned char* ws; int ph_lo, ph_hi; };
enum { I_X = 0, I_C, I_CTX, I_CCTX, I_WMOD, I_BMOD, I_NPRE, I_NPOST, I_WG, I_WU, I_WD, I_WIN, I_WOUT, I_VGAIN, I_WS, I_BS, I_LAM, I_SUBLN, I_SINK };

#define LDS_WAIT() asm volatile("s_waitcnt lgkmcnt(0)" ::: "memory")

__device__ __forceinline__ void transpose_item(const float* __restrict__ W, int N, int k0, int n0, bf16_t* __restrict__ WT, int K, int drow0, LAS float* scr, int lane, float wscale = 1.0f) {
#pragma unroll 8
    for (int i = 0; i < 32; ++i) { const int kk = 2 * i + (lane >> 5); scr[kk * 33 + (lane & 31)] = __builtin_nontemporal_load(W + (size_t)(k0 + kk) * N + n0 + (lane & 31)); }
    LDS_WAIT(); asm volatile("" ::: "memory");
    const int c = lane & 7;
#pragma unroll
    for (int j = 0; j < 4; ++j) { const int n = (lane >> 3) + 8 * j; const LAS float* s = scr + (8 * c) * 33 + n;
        u32x4 o; o.x = cvt_pk_bf16(s[0 * 33] * wscale, s[1 * 33] * wscale); o.y = cvt_pk_bf16(s[2 * 33] * wscale, s[3 * 33] * wscale); o.z = cvt_pk_bf16(s[4 * 33] * wscale, s[5 * 33] * wscale); o.w = cvt_pk_bf16(s[6 * 33] * wscale, s[7 * 33] * wscale);
        __builtin_nontemporal_store(o, (u32x4*)(WT + (size_t)(drow0 + n0 + n) * K + k0 + 8 * c)); }
    LDS_WAIT(); asm volatile("" ::: "memory");
}

__device__ __forceinline__ void prologue_a(const Args& a, LAS unsigned char* lds, int tid, int G) {
    const int lane = tid & 63, wave = tid >> 6;
    unsigned char* ws = a.ws;
    {
        LAS float* scr = (LAS float*)(lds + wave * 16384);
        const int gw = blockIdx.x * 8 + wave, NGW = G * 8;
        constexpr int PER_L = 10240;
        for (int it = gw; it < DEPTH * PER_L; it += NGW) {
            const int l = it / PER_L; int r = it % PER_L;
            if (r < 5632) {
                const int up = r >= 2816; if (up) r -= 2816;
                const int sub = r / 1408, rr = r % 1408, kb = rr / 88, nb = rr % 88, n0 = nb * 32;
                const float* W = a.in[up ? I_WU : I_WG] + (size_t)(l * 2 + sub) * DM * DFF;
                bf16_t* WT = (bf16_t*)(ws + WS_WGU) + (size_t)(l * 2 + sub) * NGU * DM;
                transpose_item(W, DFF, kb * 64, n0, WT, DM, 256 * (n0 >> 7) + (up ? 128 : 0) + (n0 & 127) - n0, scr, lane, up ? (1.0f / LOG2E) : LOG2E);
            } else if (r < 8448) {
                r -= 5632; const int sub = r / 1408, rr = r % 1408, kb = rr / 32, nb = rr % 32;
                const float* W = a.in[I_WD] + (size_t)(l * 2 + sub) * DFF * DM;
                bf16_t* WT = (bf16_t*)(ws + WS_WD) + (size_t)(l * 2 + sub) * DM * DFF;
                transpose_item(W, DM, kb * 64, nb * 32, WT, DFF, 0, scr, lane);
            } else if (r < 9728) {
                r -= 8448; const int kb = r / 80, nb = r % 80;
                transpose_item(a.in[I_WIN] + (size_t)l * DM * INC, INC, kb * 64, nb * 32, (bf16_t*)(ws + WS_WIN) + (size_t)l * INC * DM, DM, 0, scr, lane);
            } else {
                r -= 9728; const int kb = r / 32, nb = r % 32;
                transpose_item(a.in[I_WOUT] + (size_t)l * DM * DM, DM, kb * 64, nb * 32, (bf16_t*)(ws + WS_WOUT) + (size_t)l * DM * DM, DM, 0, scr, lane);
            }
        }
        const float* wsrc = a.in[I_WS]; bf16_t* wdst = (bf16_t*)(ws + WS_WS);
        for (int i = (blockIdx.x * 512 + tid); i < DEPTH * 4 * 128 * 128 / 8; i += G * 512) {
            const f32x4 v0 = *(const f32x4*)(wsrc + (size_t)i * 8), v1 = *(const f32x4*)(wsrc + (size_t)i * 8 + 4);
            *(u32x4*)(wdst + (size_t)i * 8) = (u32x4){cvt_pk_bf16(v0[0], v0[1]), cvt_pk_bf16(v0[2], v0[3]), cvt_pk_bf16(v1[0], v1[1]), cvt_pk_bf16(v1[2], v1[3])};
        }
    }
    __syncthreads();
    {
        LAS float* sc = (LAS float*)lds;
        LAS float* red = (LAS float*)(lds + 9 * 1024 * 4);
        for (int i = tid; i < 9 * 1024; i += 512) { const int m = i >> 10, k = i & 1023; const float v = (m < 8) ? a.in[I_C][m * 1024 + k] : a.in[I_CCTX][k]; sc[i] = silu_f(v); }
        __syncthreads();
        float* MOD = (float*)(ws + WS_MOD);
        const int kq = tid >> 7, jj = tid & 127;
        for (int it = blockIdx.x; it < DEPTH * 72; it += G) {
            const int l = it / 72, cb = it % 72, col = cb * 128 + jj;
            const float* wp = a.in[I_WMOD] + (size_t)l * DM * 9216 + col;
            float acc[9];
#pragma unroll
            for (int m = 0; m < 9; ++m) acc[m] = 0.f;
#pragma unroll 4
            for (int k = kq * 256; k < kq * 256 + 256; ++k) {
                const float w = __builtin_nontemporal_load(wp + (size_t)k * 9216);
#pragma unroll
                for (int m = 0; m < 9; ++m) acc[m] += sc[m * 1024 + k] * w;
            }
#pragma unroll
            for (int m = 0; m < 9; ++m) red[(kq * 9 + m) * 128 + jj] = acc[m];
            __syncthreads();
            for (int o = tid; o < 9 * 128; o += 512) { const int m = o >> 7, j2 = o & 127;
                const float v = red[(0 * 9 + m) * 128 + j2] + red[(1 * 9 + m) * 128 + j2] + red[(2 * 9 + m) * 128 + j2] + red[(3 * 9 + m) * 128 + j2];
                MOD[((size_t)l * 9 + m) * 9216 + cb * 128 + j2] = v + a.in[I_BMOD][l * 9216 + cb * 128 + j2]; }
            __syncthreads();
        }
    }
    if (blockIdx.x == 0) {
        f32x2* rope = (f32x2*)(ws + WS_ROPE);
        for (int i = tid; i < 64 * 16; i += 512) { const int pos = i >> 4, j = i & 15; const float inv = powf(10000.0f, -(float)j / 16.0f); const float ang = (float)pos * inv; rope[i] = (f32x2){cosf(ang), sinf(ang)}; }
    }
    if (blockIdx.x == (G > 1 ? 1 : 0) && wave == 0) {
        float* LAM = (float*)(ws + WS_LAM);
        for (int l = 0; l < DEPTH; ++l) {
            const float* lp = a.in[I_LAM] + l * 256;
            const float s1 = wave_sum(lp[lane] * lp[64 + lane]), s2 = wave_sum(lp[128 + lane] * lp[192 + lane]);
            const float lam_init = 0.8f - 0.6f * expf(-0.3f * (float)l);
            if (lane == 0) { LAM[l] = expf(s1) - expf(s2) + lam_init; LAM[4 + l] = 1.0f - lam_init; }
        }
    }
}

__device__ __forceinline__ void unpack8(const u32x4 w, f32x4& lo, f32x4& hi) {
    lo = (f32x4){__uint_as_float(w.x << 16), __uint_as_float(w.x & 0xffff0000u), __uint_as_float(w.y << 16), __uint_as_float(w.y & 0xffff0000u)};
    hi = (f32x4){__uint_as_float(w.z << 16), __uint_as_float(w.z & 0xffff0000u), __uint_as_float(w.w << 16), __uint_as_float(w.w & 0xffff0000u)};
}
__device__ __forceinline__ void norm_phase(const Args& a, LAS unsigned char* lds, int l, int j, int l2, int j2, int nrows, float wgt, int tid, int G) {
    const int lane = tid & 63, wave = tid >> 6;
    unsigned char* ws = a.ws;
    const float* MOD = (const float*)(ws + WS_MOD);
    const bf16_t* Z = (const bf16_t*)(ws + WS_Z);
    bf16_t* S16 = (bf16_t*)(ws + WS_S16);
    bf16_t* Y = (bf16_t*)(ws + WS_Y);
    const int NW = G * 8, gw = blockIdx.x * 8 + wave;
    const int lc = (T_LAT + NW - 1) / NW, cc = (nrows > T_LAT) ? (nrows - T_LAT + NW - 1) / NW : 0;
    const int la = gw * lc < T_LAT ? gw * lc : T_LAT, lb = (la + lc < T_LAT) ? la + lc : T_LAT;
    const int ca0 = T_LAT + gw * cc, ca = ca0 < nrows ? ca0 : nrows, cb = (ca + cc < nrows) ? ca + cc : nrows;
    const int nmine = (lb - la) + (cb - ca);
#define NORM_ROW(i_) ((i_) < lb - la ? la + (i_) : ca + ((i_) - (lb - la)))
    const int cl = 8 * lane;
    const int mfirst = ((int)blockIdx.x * 8 * lc) >> 11, mlastr = ((int)blockIdx.x * 8 + 7) * lc + lc - 1, mlast = (mlastr < T_LAT ? mlastr : T_LAT - 1) >> 11;
    const bool use_lds = (mfirst == mlast) && ((int)blockIdx.x * 8 * lc < T_LAT);
    LAS f32x4* vlds = (LAS f32x4*)lds;
    if (use_lds) {
        const int set = tid >> 8, c4 = tid & 255, mm = set ? 8 : mfirst, c = 4 * c4;
        float z0_ = 0.f; asm volatile("" : "+v"(z0_));
        f32x4 av = (f32x4){z0_, z0_, z0_, z0_}, bv = av, cv = av;
        if (l >= 0) av = *(const f32x4*)(MOD + ((size_t)l * 9 + mm) * 9216 + (3 * j + 2) * DM + c) * *(const f32x4*)(a.in[I_NPOST] + (size_t)(l * 3 + j) * DM + c) * wgt;
        if (l2 < DEPTH) { const float* shift = MOD + ((size_t)l2 * 9 + mm) * 9216 + (3 * j2) * DM;
            bv = *(const f32x4*)(a.in[I_NPRE] + (size_t)(l2 * 3 + j2) * DM + c) * (*(const f32x4*)(shift + DM + c) + 1.0f); cv = *(const f32x4*)(shift + c); }
        vlds[(set * 3 + 0) * 256 + c4] = av; vlds[(set * 3 + 1) * 256 + c4] = bv; vlds[(set * 3 + 2) * 256 + c4] = cv;
    }
    __syncthreads();
    const bool final_out = (l2 >= DEPTH);
    int mcur = -1;
    f32x4 Av[4], Bv[4], Cv[4];
#pragma unroll
    for (int k = 0; k < 4; ++k) { Av[k] = (f32x4){0.f, 0.f, 0.f, 0.f}; Bv[k] = Av[k]; Cv[k] = Av[k]; }
    u32x4 zc0 = (u32x4){0u, 0u, 0u, 0u}, zc1 = zc0, qc0 = zc0, qc1 = zc0; f32x4 xc[4];
#pragma unroll
    for (int k = 0; k < 4; ++k) xc[k] = (f32x4){0.f, 0.f, 0.f, 0.f};
#define NORM_LOAD(row_, z0_, z1_, q0_, q1_, x_) do { \
        if (l < 0) { const float* src_ = ((row_) < T_LAT) ? a.in[I_X] + (size_t)(row_) * DM : a.in[I_CTX] + (size_t)((row_) - T_LAT) * DM; \
            _Pragma("unroll") for (int k = 0; k < 4; ++k) x_[k] = __builtin_nontemporal_load((const f32x4*)(src_ + 512 * (k >> 1) + cl + 4 * (k & 1))); } \
        else { z0_ = __builtin_nontemporal_load((const u32x4*)(Z + (size_t)(row_) * DM + cl)); z1_ = __builtin_nontemporal_load((const u32x4*)(Z + (size_t)(row_) * DM + 512 + cl)); \
            q0_ = __builtin_nontemporal_load((const u32x4*)(S16 + (size_t)(row_) * DM + cl)); q1_ = __builtin_nontemporal_load((const u32x4*)(S16 + (size_t)(row_) * DM + 512 + cl)); } } while (0)
    if (nmine > 0) NORM_LOAD(NORM_ROW(0), zc0, zc1, qc0, qc1, xc);
    for (int ri = 0; ri < nmine; ++ri) {
        const int row = NORM_ROW(ri);
        const bool lat = row < T_LAT;
        const int m = lat ? (row >> 11) : 8;
        u32x4 zn0 = zc0, zn1 = zc1, qn0 = qc0, qn1 = qc1; f32x4 xn[4];
#pragma unroll
        for (int k = 0; k < 4; ++k) xn[k] = xc[k];
        if (ri + 1 < nmine) { const int rown = NORM_ROW(ri + 1); NORM_LOAD(rown, zn0, zn1, qn0, qn1, xn); }
        if (m != mcur && use_lds) {
            mcur = m;
            const int set = (m == 8) ? 1 : 0;
#pragma unroll
            for (int k = 0; k < 4; ++k) { const int c4 = (512 * (k >> 1) + cl + 4 * (k & 1)) >> 2; Av[k] = vlds[(set * 3 + 0) * 256 + c4]; Bv[k] = vlds[(set * 3 + 1) * 256 + c4]; Cv[k] = vlds[(set * 3 + 2) * 256 + c4]; }
        }
        if (m != mcur) {
            mcur = m;
            if (l >= 0) {
                const float* gate = MOD + ((size_t)l * 9 + m) * 9216 + (3 * j + 2) * DM;
                const float* post = a.in[I_NPOST] + (size_t)(l * 3 + j) * DM;
#pragma unroll
                for (int k = 0; k < 4; ++k) { const int c = 512 * (k >> 1) + cl + 4 * (k & 1); Av[k] = *(const f32x4*)(gate + c) * *(const f32x4*)(post + c) * wgt; }
            }
            if (l2 < DEPTH) {
                const float* shift = MOD + ((size_t)l2 * 9 + m) * 9216 + (3 * j2) * DM;
                const float* scale = shift + DM;
                const float* pre = a.in[I_NPRE] + (size_t)(l2 * 3 + j2) * DM;
#pragma unroll
                for (int k = 0; k < 4; ++k) { const int c = 512 * (k >> 1) + cl + 4 * (k & 1); Bv[k] = *(const f32x4*)(pre + c) * (*(const f32x4*)(scale + c) + 1.0f); Cv[k] = *(const f32x4*)(shift + c); }
            }
        }
        f32x4 sv[4];
        if (l < 0) {
#pragma unroll
            for (int k = 0; k < 4; ++k) sv[k] = xc[k];
        } else {
            unpack8(qc0, sv[0], sv[1]); unpack8(qc1, sv[2], sv[3]);
            f32x4 zv[4];
            unpack8(zc0, zv[0], zv[1]); unpack8(zc1, zv[2], zv[3]);
            if (!lat) {
#pragma unroll
                for (int pp = 1; pp < 8; ++pp) { const bf16_t* zp = Z + (size_t)(row + pp * T_CTX) * DM + cl; f32x4 t0, t1, t2, t3;
                    unpack8(*(const u32x4*)zp, t0, t1); unpack8(*(const u32x4*)(zp + 512), t2, t3); zv[0] += t0; zv[1] += t1; zv[2] += t2; zv[3] += t3; }
            }
            float ss = 0.f;
#pragma unroll
            for (int k = 0; k < 4; ++k) ss += (zv[k][0] * zv[k][0] + zv[k][1] * zv[k][1]) + (zv[k][2] * zv[k][2] + zv[k][3] * zv[k][3]);
            ss = wave_sum(ss);
            const float rstd = rsqrtf(ss * (1.0f / DM) + EPSV);
#pragma unroll
            for (int k = 0; k < 4; ++k) sv[k] += Av[k] * (zv[k] * rstd);
        }
        if (final_out) {
            float* orow = a.out + (size_t)row * DM;
#pragma unroll
            for (int k = 0; k < 4; ++k) *(f32x4*)(orow + 512 * (k >> 1) + cl + 4 * (k & 1)) = sv[k];
        } else {
            __builtin_nontemporal_store((u32x4){cvt_pk_bf16(sv[0][0], sv[0][1]), cvt_pk_bf16(sv[0][2], sv[0][3]), cvt_pk_bf16(sv[1][0], sv[1][1]), cvt_pk_bf16(sv[1][2], sv[1][3])}, (u32x4*)(S16 + (size_t)row * DM + cl));
            __builtin_nontemporal_store((u32x4){cvt_pk_bf16(sv[2][0], sv[2][1]), cvt_pk_bf16(sv[2][2], sv[2][3]), cvt_pk_bf16(sv[3][0], sv[3][1]), cvt_pk_bf16(sv[3][2], sv[3][3])}, (u32x4*)(S16 + (size_t)row * DM + 512 + cl));
        }
        if (l2 < DEPTH) {
            float ss = 0.f;
#pragma unroll
            for (int k = 0; k < 4; ++k) ss += (sv[k][0] * sv[k][0] + sv[k][1] * sv[k][1]) + (sv[k][2] * sv[k][2] + sv[k][3] * sv[k][3]);
            ss = wave_sum(ss);
            const float rstd = rsqrtf(ss * (1.0f / DM) + EPSV);
            f32x4 y[4];
#pragma unroll
            for (int k = 0; k < 4; ++k) y[k] = (sv[k] * rstd) * Bv[k] + Cv[k];
            *(u32x4*)(Y + (size_t)row * DM + cl) = (u32x4){cvt_pk_bf16(y[0][0], y[0][1]), cvt_pk_bf16(y[0][2], y[0][3]), cvt_pk_bf16(y[1][0], y[1][1]), cvt_pk_bf16(y[1][2], y[1][3])};
            *(u32x4*)(Y + (size_t)row * DM + 512 + cl) = (u32x4){cvt_pk_bf16(y[2][0], y[2][1]), cvt_pk_bf16(y[2][2], y[2][3]), cvt_pk_bf16(y[3][0], y[3][1]), cvt_pk_bf16(y[3][2], y[3][3])};
        }
        zc0 = zn0; zc1 = zn1; qc0 = qn0; qc1 = qn1;
#pragma unroll
        for (int k = 0; k < 4; ++k) xc[k] = xn[k];
    }
#undef NORM_LOAD
#undef NORM_ROW
}

template <int NMAP, int VD, bool SWA>
__device__ __forceinline__ void attn_unit(LAS unsigned char* lds, const bf16_t* __restrict__ Qp, int qpitch, const bf16_t* __restrict__ Kb, const bf16_t* __restrict__ Vt,
                                          int n0, int t1lo, int t1hi, int qp0, float sink_l2, float lam, const float* __restrict__ gsub, float post_scale, bf16_t* __restrict__ Op, int tid) {
    constexpr int KW = SWA ? 64 : 64 * NMAP, KMS = SWA ? 0 : 64, KP = 144, VP = 144, NKC = KW / 64, NVC = VD / 64, NET = VD / 16;
    constexpr int KBYTES = 64 * KP * 2, BUFB = KBYTES + 64 * VP * 2;
    const int lane = tid & 63, w = tid >> 6, fr = lane & 15, fq = lane >> 4;
    bf16x8 qf[NMAP][2];
    { const bf16_t* qr = Qp + (size_t)(16 * w + fr) * qpitch + fq * 8;
#pragma unroll
      for (int mp = 0; mp < NMAP; ++mp)
#pragma unroll
          for (int ks = 0; ks < 2; ++ks) qf[mp][ks] = *(const bf16x8*)(qr + mp * 64 + ks * 32); }
    f32x4 oacc[NMAP][NET], negm[NMAP]; float mrun[NMAP], lsum[NMAP];
#pragma unroll
    for (int mp = 0; mp < NMAP; ++mp) { mrun[mp] = 0.f; lsum[mp] = 0.f; negm[mp] = (f32x4){0.f, 0.f, 0.f, 0.f};
#pragma unroll
        for (int et = 0; et < NET; ++et) oacc[mp][et] = (f32x4){0.f, 0.f, 0.f, 0.f}; }
    const int ntiles = n0 + (t1hi - t1lo);
    u32x4 kreg[NKC], vreg[NVC];
#define ATT_TILE(i) ((i) < n0 ? (i) : t1lo + ((i) - n0))
#define ATT_LOAD(tile) do { const int k0_ = (tile) * 64; \
        _Pragma("unroll") for (int i_ = 0; i_ < NKC; ++i_) { const int c_ = tid + 512 * i_, key_ = c_ / (KW / 8), cc_ = c_ % (KW / 8); kreg[i_] = *(const u32x4*)(Kb + (size_t)(k0_ + key_) * KW + cc_ * 8); } \
        _Pragma("unroll") for (int i_ = 0; i_ < NVC; ++i_) { const int c_ = tid + 512 * i_, key_ = c_ / (VD / 8), cc_ = c_ % (VD / 8); vreg[i_] = *(const u32x4*)(Vt + (size_t)(k0_ + key_) * VD + cc_ * 8); } } while (0)
#define ATT_STORE(buf) do { LAS bf16_t* kS_ = (LAS bf16_t*)(lds + (buf) * BUFB); LAS bf16_t* vS_ = (LAS bf16_t*)(lds + (buf) * BUFB + KBYTES); \
        _Pragma("unroll") for (int i_ = 0; i_ < NKC; ++i_) { const int c_ = tid + 512 * i_, key_ = c_ / (KW / 8), cc_ = c_ % (KW / 8); *(LAS u32x4*)(kS_ + key_ * KP + cc_ * 8) = kreg[i_]; } \
        _Pragma("unroll") for (int i_ = 0; i_ < NVC; ++i_) { const int c_ = tid + 512 * i_, key_ = c_ / (VD / 8), cc_ = c_ % (VD / 8); *(LAS u32x4*)(vS_ + key_ * VP + cc_ * 8) = vreg[i_]; } } while (0)
    ATT_LOAD(ATT_TILE(0));
    ATT_STORE(0);
    if (ntiles > 1) ATT_LOAD(ATT_TILE(1));
    __syncthreads();
    for (int i = 0; i < ntiles; ++i) {
        const int t = ATT_TILE(i);
        if (i + 1 < ntiles) { ATT_STORE((i + 1) & 1); if (i + 2 < ntiles) ATT_LOAD(ATT_TILE(i + 2)); }
        const LAS bf16_t* kS = (const LAS bf16_t*)(lds + (i & 1) * BUFB);
        const LAS bf16_t* vS = (const LAS bf16_t*)(lds + (i & 1) * BUFB + KBYTES);
        bf16x8 pf[NMAP][2];
        f32x4 sacc[NMAP][4];
#pragma unroll
        for (int mp = 0; mp < NMAP; ++mp) {
            bf16x8 kf[4][2];
#pragma unroll
            for (int kt = 0; kt < 4; ++kt)
#pragma unroll
                for (int ks = 0; ks < 2; ++ks) kf[kt][ks] = *(const LAS bf16x8*)(kS + (16 * kt + fr) * KP + mp * KMS + ks * 32 + fq * 8);
            __builtin_amdgcn_sched_barrier(0);
#pragma unroll
            for (int kt = 0; kt < 4; ++kt) sacc[mp][kt] = __builtin_amdgcn_mfma_f32_16x16x32_bf16(kf[kt][0], qf[mp][0], negm[mp], 0, 0, 0);
#pragma unroll
            for (int kt = 0; kt < 4; ++kt) sacc[mp][kt] = __builtin_amdgcn_mfma_f32_16x16x32_bf16(kf[kt][1], qf[mp][1], sacc[mp][kt], 0, 0, 0);
        }
        bf16x8 va[4];
#define ATT_LDV(dst, idx) do { const LAS bf16_t* vp_ = vS + (32 * ((idx) / NET) + 4 * fq + (fr >> 2)) * VP + 16 * ((idx) % NET) + 4 * (fr & 3); \
            const s16x4 lo_ = __builtin_amdgcn_ds_read_tr16_b64_v4i16((LAS s16x4*)vp_), hi_ = __builtin_amdgcn_ds_read_tr16_b64_v4i16((LAS s16x4*)(vp_ + 16 * VP)); \
            dst = (bf16x8){lo_[0], lo_[1], lo_[2], lo_[3], hi_[0], hi_[1], hi_[2], hi_[3]}; } while (0)
#pragma unroll
        for (int i2 = 0; i2 < 4; ++i2) ATT_LDV(va[i2], i2);
        if (SWA && t >= 4) {
            const int dq = qp0 + 16 * w + fr - (64 * (t - 4) + 4 * fq);
#pragma unroll
            for (int kt = 0; kt < 4; ++kt)
#pragma unroll
                for (int r = 0; r < 4; ++r) { const int d = dq - 16 * kt - r; if (d > 128 || d < -128) {
#pragma unroll
                    for (int mp = 0; mp < NMAP; ++mp) sacc[mp][kt][r] = -INFINITY; } }
        }
        float mx[NMAP];
#pragma unroll
        for (int mp = 0; mp < NMAP; ++mp) {
            float v = fmax2(fmax2(sacc[mp][0][0], sacc[mp][0][1]), fmax2(sacc[mp][0][2], sacc[mp][0][3]));
#pragma unroll
            for (int kt = 1; kt < 4; ++kt) v = fmax2(v, fmax2(fmax2(sacc[mp][kt][0], sacc[mp][kt][1]), fmax2(sacc[mp][kt][2], sacc[mp][kt][3])));
            mx[mp] = v;
        }
#pragma unroll
        for (int mp = 0; mp < NMAP; ++mp) mx[mp] = fmax2(mx[mp], __shfl_xor(mx[mp], 16));
#pragma unroll
        for (int mp = 0; mp < NMAP; ++mp) mx[mp] = fmax2(mx[mp], __shfl_xor(mx[mp], 32));
#pragma unroll
        for (int mp = 0; mp < NMAP; ++mp) {
            if (i == 0 || __builtin_amdgcn_ballot_w64(mx[mp] > 8.0f) != 0ull) {
                const float delta = (i == 0) ? mx[mp] : fmaxf(mx[mp], 0.f), alpha = (i == 0) ? 0.f : __builtin_amdgcn_exp2f(-delta);
                mrun[mp] += delta; negm[mp] = (f32x4){-mrun[mp], -mrun[mp], -mrun[mp], -mrun[mp]}; lsum[mp] *= alpha;
#pragma unroll
                for (int kt = 0; kt < 4; ++kt) sacc[mp][kt] = sacc[mp][kt] - delta;
#pragma unroll
                for (int et = 0; et < NET; ++et) oacc[mp][et] = oacc[mp][et] * alpha;
            }
            float ps = 0.f;
#pragma unroll
            for (int kt = 0; kt < 4; ++kt)
#pragma unroll
                for (int r = 0; r < 4; ++r) { const float p = __builtin_amdgcn_exp2f(sacc[mp][kt][r]); sacc[mp][kt][r] = p; ps += p; }
            lsum[mp] += ps;
#pragma unroll
            for (int s2 = 0; s2 < 2; ++s2) {
                u32x4 pk; pk.x = cvt_pk_bf16(sacc[mp][2 * s2][0], sacc[mp][2 * s2][1]); pk.y = cvt_pk_bf16(sacc[mp][2 * s2][2], sacc[mp][2 * s2][3]);
                pk.z = cvt_pk_bf16(sacc[mp][2 * s2 + 1][0], sacc[mp][2 * s2 + 1][1]); pk.w = cvt_pk_bf16(sacc[mp][2 * s2 + 1][2], sacc[mp][2 * s2 + 1][3]);
                pf[mp][s2] = __builtin_bit_cast(bf16x8, pk);
            }
        }
#pragma unroll
        for (int idx = 0; idx < 2 * NET; ++idx) {
            const int et = idx % NET, s2 = idx / NET;
            const bf16x8 cur = va[idx & 3];
            if (idx + 4 < 2 * NET) ATT_LDV(va[idx & 3], idx + 4);
#pragma unroll
            for (int mp = 0; mp < NMAP; ++mp) oacc[mp][et] = __builtin_amdgcn_mfma_f32_16x16x32_bf16(cur, pf[mp][s2], oacc[mp][et], 0, 0, 0);
        }
#undef ATT_LDV
        __syncthreads();
    }
#undef ATT_TILE
#undef ATT_LOAD
#undef ATT_STORE
    float lt[NMAP];
#pragma unroll
    for (int mp = 0; mp < NMAP; ++mp) { float v = lsum[mp]; v += __shfl_xor(v, 16); v += __shfl_xor(v, 32); lt[mp] = v; }
    bf16_t* orow = Op + (size_t)(16 * w + fr) * DM + 4 * fq;
    if constexpr (!SWA) {
        const float inv0 = 1.0f / lt[0], inv1 = lam / lt[1];
        float ss = 0.f;
#pragma unroll
        for (int et = 0; et < NET; ++et)
#pragma unroll
            for (int r = 0; r < 4; ++r) { const float o = oacc[0][et][r] * inv0 - oacc[1][et][r] * inv1; oacc[0][et][r] = o; ss += o * o; }
        ss += __shfl_xor(ss, 16); ss += __shfl_xor(ss, 32);
        const float rstd = rsqrtf(ss * (1.0f / VD) + EPSV) * post_scale;
#pragma unroll
        for (int et = 0; et < NET; ++et) { const f32x4 g = *(const f32x4*)(gsub + 16 * et + 4 * fq); const f32x4 v = oacc[0][et] * rstd * g;
            *(u32x2*)(orow + 16 * et) = (u32x2){cvt_pk_bf16(v[0], v[1]), cvt_pk_bf16(v[2], v[3])}; }
    } else {
#pragma unroll
        for (int mp = 0; mp < NMAP; ++mp) {
            const float l0 = lt[mp] + __builtin_amdgcn_exp2f((mp == 0 ? sink_l2 : lam) - mrun[mp]);
            const float inv = 1.0f / l0;
#pragma unroll
            for (int et = 0; et < NET; ++et) { const f32x4 v = oacc[mp][et] * inv; *(u32x2*)(orow + mp * 64 + 16 * et) = (u32x2){cvt_pk_bf16(v[0], v[1]), cvt_pk_bf16(v[2], v[3])}; }
        }
    }
    __syncthreads();
}

__device__ __forceinline__ void gmlp_unit(LAS unsigned char* lds, const bf16_t* __restrict__ UV, const bf16_t* __restrict__ Wsb  , const float* __restrict__ gain  ,
                                          const float* __restrict__ bs  , int r0, int h, bf16_t* __restrict__ O, int tid) {
    constexpr int VP = 136;
    LAS bf16_t* vT = (LAS bf16_t*)lds;
    const int lane = tid & 63, w = tid >> 6, fr = lane & 15, fq = lane >> 4;
    {
        const int q = tid >> 2, part = tid & 3;
        const bf16_t* src = UV + (size_t)(r0 + q) * 512 + 256 + 64 * h + 16 * part;
        const u32x4 a0 = *(const u32x4*)src, a1 = *(const u32x4*)(src + 8);
        float v[16];
#pragma unroll
        for (int i = 0; i < 4; ++i) { v[2 * i] = __uint_as_float(a0[i] << 16); v[2 * i + 1] = __uint_as_float(a0[i] & 0xffff0000u); v[8 + 2 * i] = __uint_as_float(a1[i] << 16); v[8 + 2 * i + 1] = __uint_as_float(a1[i] & 0xffff0000u); }
        float ss = 0.f;
#pragma unroll
        for (int i = 0; i < 16; ++i) ss += v[i] * v[i];
        ss += __shfl_xor(ss, 1); ss += __shfl_xor(ss, 2);
        const float rstd = rsqrtf(ss * (1.0f / 64.0f) + EPSV);
#pragma unroll
        for (int i = 0; i < 16; ++i) { const int c = 16 * part + i; vT[c * VP + q] = (bf16_t)(cvt_pk_bf16(v[i] * rstd * gain[c], 0.f) & 0xffffu); }
    }
    __syncthreads();
    f32x4 acc[4];
#pragma unroll
    for (int nt = 0; nt < 4; ++nt) acc[nt] = (f32x4){0.f, 0.f, 0.f, 0.f};
#pragma unroll
    for (int ks = 0; ks < 4; ++ks) {
        const bf16x8 wf = *(const bf16x8*)(Wsb + (size_t)(16 * w + fr) * 128 + 32 * ks + 8 * fq);
#pragma unroll
        for (int nt = 0; nt < 4; ++nt) { const bf16x8 vf = *(const LAS bf16x8*)(vT + (16 * nt + fr) * VP + 32 * ks + 8 * fq);
            acc[nt] = __builtin_amdgcn_mfma_f32_16x16x32_bf16(vf, wf, acc[nt], 0, 0, 0); }
    }
    const int p = 16 * w + fr; const float bias = bs[p];
    const bf16_t* up = UV + (size_t)(r0 + p) * 512 + 64 * h + 4 * fq;
    bf16_t* op = O + (size_t)(r0 + p) * DM + 64 * h + 4 * fq;
#pragma unroll
    for (int nt = 0; nt < 4; ++nt) {
        const u32x2 uu = *(const u32x2*)(up + 16 * nt);
        const float u0 = __uint_as_float(uu.x << 16), u1 = __uint_as_float(uu.x & 0xffff0000u), u2 = __uint_as_float(uu.y << 16), u3 = __uint_as_float(uu.y & 0xffff0000u);
        *(u32x2*)(op + 16 * nt) = (u32x2){cvt_pk_bf16(u0 * (acc[nt][0] + bias), u1 * (acc[nt][1] + bias)), cvt_pk_bf16(u2 * (acc[nt][2] + bias), u3 * (acc[nt][3] + bias))};
    }
    __syncthreads();
}

__device__ __forceinline__ void mix_phase(const Args& a, LAS unsigned char* lds, int l, int tid_in, int G) {
    unsigned char* ws = a.ws;
    const bool last = (l == DEPTH - 1);
    const bf16_t* UV = (const bf16_t*)(ws + R1_UV); const bf16_t* QB = (const bf16_t*)(ws + R1_QB); const bf16_t* QC = (const bf16_t*)(ws + R1_QC);
    const bf16_t* KB = (const bf16_t*)(ws + R1_KB); const bf16_t* VBt = (const bf16_t*)(ws + R1_VB); const bf16_t* KC = (const bf16_t*)(ws + R1_KC); const bf16_t* VCt = (const bf16_t*)(ws + R1_VC);
    bf16_t* O = (bf16_t*)(ws + R1_O);
    const float* LAM = (const float*)(ws + WS_LAM);
    const float lam = LAM[l], post_scale = LAM[4 + l];
    const float* gsub = a.in[I_SUBLN] + l * 128;
    const int n_ctxd = last ? 0 : 64, n_ctxs = last ? 0 : 32, n_g = last ? 512 : 576;
    const int e0 = 512, e1 = e0 + 256, e2 = e1 + n_ctxd, e3 = e2 + n_ctxs, e4 = e3 + n_g;
    for (int u = blockIdx.x; u < e4; u += G) {
        int tid = tid_in; asm volatile("" : "+v"(tid));
        if (u < e3) {
            const bool is_swa = (u >= e0 && u < e1) || (u >= e2);
            const bool is_ctx = (u >= e1);
            int b, hh, qb, row0;
            if (u < e0) {
                const int v = u, x = v & 7, slot = (v >> 3) & 31, rnd = v >> 8, P = x * 4 + rnd * 2 + (slot >> 4);
                b = P >> 2; hh = P & 3; qb = slot & 15; row0 = b * SEQ + 128 * qb; }
            else if (u < e1) { const int v = u - e0, x = v & 7, slot = (v >> 3) & 31, P = x * 2 + (slot >> 4); b = P >> 1; hh = P & 1; qb = slot & 15; row0 = b * SEQ + 128 * qb; }
            else if (u < e2) { const int v = u - e1; b = v >> 3; hh = (v >> 1) & 3; qb = v & 1; row0 = T_LAT + b * CTXL + 128 * qb; }
            else { const int v = u - e2; b = v >> 2; hh = (v >> 1) & 1; qb = v & 1; row0 = T_LAT + b * CTXL + 128 * qb; }
            if (!is_swa) {
                attn_unit<2, 128, false>(lds, QB + (size_t)row0 * 512 + hh * 128, 512, KB + (size_t)(b * 4 + hh) * NKEY * 128, VBt + (size_t)(b * 4 + hh) * NKEY * 128,
                                         is_ctx ? 4 : 36, 0, 0, 0, 0.f, lam, gsub, post_scale, O + (size_t)row0 * DM + 256 + hh * 128, tid);
            } else {
                const int kv = hh;
                int lo = 4 + 2 * (qb - 1), hi = 4 + 2 * (qb + 2); if (lo < 4) lo = 4; if (hi > 36) hi = 36;
                if (is_ctx) { lo = 0; hi = 0; }
                attn_unit<2, 64, true>(lds, QC + (size_t)row0 * 256 + kv * 128, 256, KC + (size_t)(b * 2 + kv) * NKEY * 64, VCt + (size_t)(b * 2 + kv) * NKEY * 64,
                                       4, lo, hi, 128 * qb, a.in[I_SINK][l * 4 + kv * 2] * LOG2E, a.in[I_SINK][l * 4 + kv * 2 + 1] * LOG2E, nullptr, 0.f, O + (size_t)row0 * DM + 768 + kv * 128, tid);
            }
        } else {
            const int v = u - e3, ch = v >> 2, h = v & 3;
            gmlp_unit(lds, UV, (const bf16_t*)(ws + WS_WS) + (size_t)(l * 4 + h) * 128 * 128, a.in[I_VGAIN] + (l * 4 + h) * 64, a.in[I_BS] + (l * 4 + h) * 128, ch * 128, h, O, tid);
        }
    }
}

__global__ void __launch_bounds__(512, 2) mega_fwd(Args a) {
    extern __shared__ __attribute__((aligned(16))) unsigned char lds_raw[];
    LAS unsigned char* lds = (LAS unsigned char*)lds_raw;
    cg::grid_group grid = cg::this_grid();
    const int G = gridDim.x;
    volatile LAS unsigned* MISC = (volatile LAS unsigned*)(lds + 131072);
    if (threadIdx.x < 64) MISC[threadIdx.x] = 0u;
    __syncthreads();
    const XcdBarrier xbar = xcd_barrier_post((unsigned*)a.ws, MISC + 8);
    for (int p = a.ph_lo; p < a.ph_hi; ++p) {
        int tid = threadIdx.x; asm volatile("" : "+v"(tid));
        unsigned char* ws = a.ws; asm volatile("" : "+s"(ws));
        if (p == 0) prologue_a(a, lds, tid, G);
        else if (p == 1) norm_phase(a, lds, -1, 0, 0, 0, TT, 0.f, tid, G);
        else {
            const int q = p - 2, l = q / 10, st = q % 10; const bool last = (l == DEPTH - 1);
            const int Mfull = TT, Mlate = last ? T_LAT : TT;
            if (st == 0 || st == 7) {
                const int sub = (st == 7), M = sub ? Mlate : Mfull;
                pg8::Gemm g{(const bf16_t*)(ws + WS_Y), (const bf16_t*)(ws + WS_WGU) + (size_t)(l * 2 + sub) * NGU * DM, M, NGU, DM};
                pg8::StaticOrder S; S.init(M, NGU, G, (int)blockIdx.x); S.nkt = DM / pg8::BK;
                pg8::EpiSwiGLU E{(bf16_t*)(ws + WS_R1)};
                pg8::gemm_phase<pg8::EpiSwiGLU, pg8::StaticOrder, true, true>(lds, g, S, E, tid);
            } else if (st == 1 || st == 8 || st == 5) {
                pg8::Gemm g; int M;
                if (st == 5) { M = Mlate; g = pg8::Gemm{(const bf16_t*)(ws + R1_O), (const bf16_t*)(ws + WS_WOUT) + (size_t)l * DM * DM, M, DM, DM}; }
                else { const int sub = (st == 8); M = sub ? Mlate : Mfull; g = pg8::Gemm{(const bf16_t*)(ws + WS_R1), (const bf16_t*)(ws + WS_WD) + (size_t)(l * 2 + sub) * DM * DFF, M, DM, DFF}; }
                pg8::SplitOrder S; S.init(M, g.K, G, (int)blockIdx.x);
                pg8::EpiZ16 E{(bf16_t*)(ws + WS_Z)};
                pg8::gemm_phase<pg8::EpiZ16, pg8::SplitOrder, true, true>(lds, g, S, E, tid);
            } else if (st == 3) {
                pg8::Gemm g{(const bf16_t*)(ws + WS_Y), (const bf16_t*)(ws + WS_WIN) + (size_t)l * INC * DM, Mfull, INC, DM};
                pg8::StaticOrder S; S.init(Mfull, INC, G, (int)blockIdx.x); S.nkt = DM / pg8::BK;
                pg8::EpiInProj E{(bf16_t*)(ws + R1_UV), (bf16_t*)(ws + R1_QB), (bf16_t*)(ws + R1_QC), (bf16_t*)(ws + R1_KB), (bf16_t*)(ws + R1_VB), (bf16_t*)(ws + R1_KC), (bf16_t*)(ws + R1_VC), (const f32x2*)(ws + WS_ROPE)};
                pg8::gemm_phase<pg8::EpiInProj, pg8::StaticOrder, true, true>(lds, g, S, E, tid);
            } else if (st == 4) {
                mix_phase(a, lds, l, tid, G);
            } else {
                const int j = (st == 2) ? 0 : (st == 6 ? 1 : 2);
                const int l2 = (j == 2) ? l + 1 : l, j2 = (j == 2) ? 0 : j + 1;
                const int nrows = (j == 0) ? Mfull : Mlate;
                norm_phase(a, lds, l, j, l2, j2, nrows, (j == 1) ? 1.0f : 0.5f, tid, G);
            }
        }
        if (p + 1 < a.ph_hi) { if (a.ph_hi > NPHASE) grid.sync(); else xcd_barrier(xbar); }
    }
}

extern "C" void kernel_launch(void* const* d_in, const int* in_sizes, int n_in, void* d_out, int out_size, void* d_ws, size_t ws_size, hipStream_t stream) {
    static int grid = 0;
    if (grid == 0) {
        if (n_in != 19 || out_size != T_LAT * DM || ws_size < WS_NEED) { fprintf(stderr, "kernel_launch: unexpected shapes (n_in %d out %d ws %zu)\n", n_in, out_size, ws_size); grid = -1; return; }
        int dev = 0, cus = 0, per_cu = 0;
        (void)hipGetDevice(&dev);
        (void)hipDeviceGetAttribute(&cus, hipDeviceAttributeMultiprocessorCount, dev);
        if (hipFuncSetAttribute((const void*)mega_fwd, hipFuncAttributeMaxDynamicSharedMemorySize, LDS_BYTES) != hipSuccess) { fprintf(stderr, "kernel_launch: hipFuncSetAttribute failed\n"); grid = -1; return; }
        if (hipOccupancyMaxActiveBlocksPerMultiprocessor(&per_cu, (const void*)mega_fwd, 512, LDS_BYTES) != hipSuccess || per_cu < 1) { fprintf(stderr, "kernel_launch: occupancy query gave %d\n", per_cu); per_cu = 1; }
        (void)hipGetLastError();
        grid = cus * 1;
        if (grid <= 0) grid = 256;
    }
    if (grid < 0) return;
    (void)hipMemsetAsync(d_ws, 0, 65536, stream);
    Args a{};
    for (int i = 0; i < 19; ++i) a.in[i] = (const float*)d_in[i];
    a.out = (float*)d_out; a.ws = (unsigned char*)d_ws; a.ph_lo = 0; a.ph_hi = NPHASE;
    void* args[] = {&a};
    hipError_t e = hipLaunchCooperativeKernel((const void*)mega_fwd, dim3(grid), dim3(512), args, LDS_BYTES, stream);
    if (e != hipSuccess) fprintf(stderr, "kernel_launch: cooperative launch failed: %s (grid %d)\n", hipGetErrorString(e), grid);
}
```
